# Optimizing an MI355X kernel written in HIP

```python
import jax, jax.numpy as jnp
from jax import lax
import numpy as np

D_MODEL = 2048
BATCH = 2
SEQ = 4096
DEPTH = 4

CHUNK = 64
N_MIXERS = 3
EPS = 1e-6
N_A = (DEPTH + 2) // 3
N_B = (DEPTH + 1) // 3
N_C = DEPTH // 3
POOL_WINDOWS = (2, 4, 8, 16)
N_POOL_GROUPS = len(POOL_WINDOWS)
POOL_GROUP = D_MODEL // N_POOL_GROUPS
HEAD_DIM = 128
N_HEADS = D_MODEL // HEAD_DIM
N_KV_HEADS = 4
KV_REP = N_HEADS // N_KV_HEADS
IDX_HEADS = 16
IDX_DIM = 64
INDEX_TOPK = 256
Q_BLOCK = 128
ROPE_THETA = 500000.0
ROT_FRACTION = 4
B_SIZES = (N_HEADS * HEAD_DIM, N_KV_HEADS * HEAD_DIM, N_KV_HEADS * HEAD_DIM,
           IDX_HEADS * IDX_DIM, IDX_DIM, IDX_HEADS)
B_COLS = sum(B_SIZES)
B_SPLITS = [int(c) for c in np.cumsum(B_SIZES)[:-1]]
SGU_BLOCK = 128
SGU_GROUPS = 8
SGU_WIDTH = D_MODEL
SGU_GROUP_DIM = SGU_WIDTH // SGU_GROUPS
D_FF = 4 * D_MODEL

kernel_name = "hybrid_pool_dsa_sgu_trunk"


def rmsnorm(x, g):
    xf = x.astype(jnp.float32)
    y = xf * lax.rsqrt(jnp.mean(xf * xf, axis=-1, keepdims=True) + EPS)
    return (y * g.astype(jnp.float32)).astype(x.dtype)


def rope(x, pos):
    rot = x.shape[-1] // ROT_FRACTION
    half = rot // 2
    inv = ROPE_THETA ** (-jnp.arange(half, dtype=jnp.float32) / half)
    ang = pos.astype(jnp.float32)[:, None] * inv[None, :]
    cos = jnp.cos(ang)[None, :, None, :]
    sin = jnp.sin(ang)[None, :, None, :]
    xf = x[..., :rot].astype(jnp.float32)
    x1, x2 = xf[..., :half], xf[..., half:]
    rotated = jnp.concatenate([x1 * cos - x2 * sin, x2 * cos + x1 * sin], axis=-1).astype(x.dtype)
    return jnp.concatenate([rotated, x[..., rot:]], axis=-1)


def pool_mixer(h, w_groups, scale):
    b, s, d = h.shape
    hf = h.astype(jnp.float32)
    cs = jnp.cumsum(hf, axis=1)
    t1 = jnp.arange(1, s + 1, dtype=jnp.float32)[None, :, None]
    outs = []
    for g, w in enumerate(POOL_WINDOWS):
        sl = slice(g * POOL_GROUP, (g + 1) * POOL_GROUP)
        c = cs[:, :, sl]
        lower = jnp.pad(c[:, :s - w], ((0, 0), (w, 0), (0, 0)))
        mean = (c - lower) / jnp.minimum(t1, float(w))
        outs.append(mean - hf[:, :, sl])
    p = jnp.stack(outs, axis=2).astype(h.dtype)
    y = jnp.einsum('bsgc,gce->bsge', p, w_groups).reshape(b, s, d)
    return y * scale


def sparse_attention(h, w_in, q_gain, k_gain, w_o, pos):
    b, s, d = h.shape
    n_sel = min(INDEX_TOPK, s // 4)
    nb = s // Q_BLOCK
    q, k, v, qi, ki, wi = jnp.split(h @ w_in, B_SPLITS, axis=-1)
    q = rope(rmsnorm(q.reshape(b, s, N_HEADS, HEAD_DIM), q_gain), pos)
    k = rope(rmsnorm(k.reshape(b, s, N_KV_HEADS, HEAD_DIM), k_gain), pos)
    v = v.reshape(b, s, N_KV_HEADS, HEAD_DIM)
    qi = rope(qi.reshape(b, s, IDX_HEADS, IDX_DIM), pos)
    ki = rope(ki[:, :, None, :], pos)[:, :, 0, :]
    wi = wi * (IDX_HEADS ** -0.5)
    key_chunk = jnp.arange(s) // CHUNK

    def to_blocks(a):
        return a.reshape(b, nb, Q_BLOCK, *a.shape[2:]).swapaxes(0, 1)

    def block(args):
        qb, qib, wib, t0 = args
        q_chunk = (t0 + jnp.arange(Q_BLOCK)) // CHUNK
        adm = key_chunk[None, :] <= q_chunk[:, None]
        rel = jax.nn.relu(jnp.einsum('bqhd,bsd->bqhs', qib, ki).astype(jnp.float32) * (IDX_DIM ** -0.5))
        score = jnp.einsum('bqhs,bqh->bqs', rel, wib.astype(jnp.float32))
        score = jnp.where(adm[None], score, -jnp.inf)
        _, idx = lax.top_k(score, n_sel)
        valid = key_chunk[idx] <= q_chunk[None, :, None]
        kg = jax.vmap(lambda a, i: a[i])(k, idx)
        vg = jax.vmap(lambda a, i: a[i])(v, idx)
        qg = qb.reshape(b, Q_BLOCK, N_KV_HEADS, KV_REP, HEAD_DIM)
        lg = jnp.einsum('bqgrd,bqkgd->bqgrk', qg, kg).astype(jnp.float32) * (HEAD_DIM ** -0.5)
        lg = jnp.where(valid[:, :, None, None, :], lg, -jnp.inf)
        p = jax.nn.softmax(lg, axis=-1).astype(vg.dtype)
        o = jnp.einsum('bqgrk,bqkgd->bqgrd', p, vg)
        return o.reshape(b, Q_BLOCK, N_HEADS * HEAD_DIM)

    starts = jnp.arange(nb) * Q_BLOCK
    o = lax.map(block, (to_blocks(q), to_blocks(qi), to_blocks(wi), starts))
    o = o.swapaxes(0, 1).reshape(b, s, N_HEADS * HEAD_DIM)
    return o @ w_o


def spatial_gating(h, w_in, b_in, v_gain, w_s, b_s, w_o):
    b, s, d = h.shape
    nblk = s // SGU_BLOCK
    z = jax.nn.gelu(h @ w_in + b_in, approximate=False)
    u, v = jnp.split(z, 2, axis=-1)
    v = rmsnorm(v, v_gain)
    vb = v.reshape(b, nblk, SGU_BLOCK, SGU_GROUPS, SGU_GROUP_DIM)
    i = jnp.arange(SGU_BLOCK)
    mask = (i[None, :] // CHUNK) <= (i[:, None] // CHUNK)
    ws = jnp.where(mask[None], w_s, 0.0).astype(v.dtype)
    mixed = jnp.einsum('gij,bnjgc->bnigc', ws, vb) + b_s.T[None, None, :, :, None]
    return (u * mixed.reshape(b, s, SGU_WIDTH)) @ w_o


def setup_inputs(seed: int = 0) -> dict:
    key = jax.random.key(seed)
    ks = jax.random.split(key, 20)
    f32 = jnp.float32
    nrm = lambda k, shape, fan: jax.random.normal(k, shape, f32) * (fan ** -0.5)
    gain = lambda k, shape: 1.0 + 0.02 * jax.random.normal(k, shape, f32)
    return {
        "x": jax.random.normal(ks[0], (BATCH, SEQ, D_MODEL), f32),
        "norm_mix": gain(ks[1], (DEPTH, D_MODEL)),
        "norm_ffn": gain(ks[2], (DEPTH, D_MODEL)),
        "pool_w": nrm(ks[3], (N_A, N_POOL_GROUPS, POOL_GROUP, POOL_GROUP), POOL_GROUP),
        "pool_scale": 1.0 + 0.1 * jax.random.normal(ks[4], (N_A, D_MODEL), f32),
        "attn_w_in": nrm(ks[5], (N_B, D_MODEL, B_COLS), D_MODEL),
        "attn_q_gain": gain(ks[6], (N_B, HEAD_DIM)),
        "attn_k_gain": gain(ks[7], (N_B, HEAD_DIM)),
        "attn_w_o": nrm(ks[8], (N_B, N_HEADS * HEAD_DIM, D_MODEL), N_HEADS * HEAD_DIM),
        "sgu_w_in": nrm(ks[9], (N_C, D_MODEL, 2 * SGU_WIDTH), D_MODEL),
        "sgu_b_in": 0.02 * jax.random.normal(ks[10], (N_C, 2 * SGU_WIDTH), f32),
        "sgu_v_gain": gain(ks[11], (N_C, SGU_WIDTH)),
        "sgu_w_s": nrm(ks[12], (N_C, SGU_GROUPS, SGU_BLOCK, SGU_BLOCK), SGU_BLOCK),
        "sgu_b_s": 1.0 + 0.1 * jax.random.normal(ks[13], (N_C, SGU_GROUPS, SGU_BLOCK), f32),
        "sgu_w_o": nrm(ks[14], (N_C, SGU_WIDTH, D_MODEL), SGU_WIDTH),
        "ffn_w_up": nrm(ks[15], (DEPTH, D_MODEL, D_FF), D_MODEL),
        "ffn_w_down": nrm(ks[16], (DEPTH, D_FF, D_MODEL), D_FF),
    }


def reference(x, norm_mix, norm_ffn, pool_w, pool_scale, attn_w_in, attn_q_gain, attn_k_gain,
              attn_w_o, sgu_w_in, sgu_b_in, sgu_v_gain, sgu_w_s, sgu_b_s, sgu_w_o,
              ffn_w_up, ffn_w_down):
    pos = jnp.arange(x.shape[1])
    for i in range(DEPTH):
        kind, j = i % N_MIXERS, i // N_MIXERS
        h = rmsnorm(x, norm_mix[i])
        if kind == 0:
            y = pool_mixer(h, pool_w[j], pool_scale[j])
        elif kind == 1:
            y = sparse_attention(h, attn_w_in[j], attn_q_gain[j], attn_k_gain[j], attn_w_o[j], pos)
        else:
            y = spatial_gating(h, sgu_w_in[j], sgu_b_in[j], sgu_v_gain[j], sgu_w_s[j], sgu_b_s[j], sgu_w_o[j])
        x = x + y
        h = rmsnorm(x, norm_ffn[i])
        x = x + jnp.square(jax.nn.relu(h @ ffn_w_up[i])) @ ffn_w_down[i]
    return x
```

```cpp
#include <hip/hip_runtime.h>
#include <hip/hip_cooperative_groups.h>
#include <cstdio>
namespace cg = cooperative_groups;

#ifndef ONE_LAUNCH
#define ONE_LAUNCH 1
#endif

#ifndef REPEAT_PH
#define REPEAT_PH -1
#endif
#define LAS __attribute__((address_space(3)))
typedef unsigned short bf16_t;
typedef short bf16x8 __attribute__((ext_vector_type(8)));
typedef float f32x4 __attribute__((ext_vector_type(4)));
typedef float f32x16 __attribute__((ext_vector_type(16)));
typedef float f32x2 __attribute__((ext_vector_type(2)));
typedef unsigned u32x4 __attribute__((ext_vector_type(4)));
typedef unsigned u32x2 __attribute__((ext_vector_type(2)));

constexpr int T = 8192, D = 2048, SEQ = 4096, FF = 8192, NIN = 4176, NINP = 4352;
constexpr int LDS_BYTES = 4096 + 8 * 16384;
constexpr int NPHASE = 20;

constexpr size_t WS_WPOOL = 0;
constexpr size_t WS_WAIN = WS_WPOOL + (size_t)2 * 4 * 512 * 512 * 2;
constexpr size_t WS_WAO = WS_WAIN + (size_t)NINP * 2048 * 2;
constexpr size_t WS_WSIN = WS_WAO + (size_t)2048 * 2048 * 2;
constexpr size_t WS_WSO = WS_WSIN + (size_t)4096 * 2048 * 2;
constexpr size_t WS_WUP = WS_WSO + (size_t)2048 * 2048 * 2;
constexpr size_t WS_WDN = WS_WUP + (size_t)4 * 8192 * 2048 * 2;
constexpr size_t WS_XF = WS_WDN + (size_t)4 * 8192 * 2048 * 2;
constexpr size_t WS_XB = WS_XF + (size_t)T * D * 4;
constexpr size_t WS_AB = WS_XB + (size_t)T * D * 2;
constexpr size_t WS_BIG = WS_AB + (size_t)T * D * 2;
constexpr size_t WS_QB = WS_BIG + (size_t)T * NINP * 4;
constexpr size_t WS_KB = WS_QB + (size_t)T * 2048 * 2;
constexpr size_t WS_VB = WS_KB + (size_t)T * 512 * 2;
constexpr size_t WS_QIB = WS_VB + (size_t)T * 512 * 2;
constexpr size_t WS_KIB = WS_QIB + (size_t)T * 1024 * 2;
constexpr size_t WS_WI = WS_KIB + (size_t)T * 64 * 2;
constexpr size_t WS_STATS = WS_WI + (size_t)T * 16 * 4;
constexpr size_t WS_BAR = WS_STATS + (size_t)8 * T * 8;
constexpr size_t WS_RAWT = WS_BAR + 16384;
constexpr size_t WS_END = WS_RAWT + (size_t)4 * T * 256 * 4;

struct Params {
    const float *x, *norm_mix, *norm_ffn, *pool_w, *pool_scale, *attn_w_in, *attn_q_gain, *attn_k_gain, *attn_w_o, *sgu_w_in, *sgu_b_in, *sgu_v_gain, *sgu_w_s, *sgu_b_s,
        *sgu_w_o, *ffn_w_up, *ffn_w_down;
    float* out;
    unsigned char* ws;
    int phase_lo, phase_hi;
};

__device__ __forceinline__ unsigned cvt_pk_bf16(float lo, float hi) { unsigned r; asm volatile("v_cvt_pk_bf16_f32 %0, %1, %2" : "=v"(r) : "v"(lo), "v"(hi)); return r; }
__device__ __forceinline__ float bf_lo(unsigned v) { return __uint_as_float(v << 16); }
__device__ __forceinline__ float bf_hi(unsigned v) { return __uint_as_float(v & 0xffff0000u); }
__device__ __forceinline__ float wave_sum(float v) {
#pragma unroll
    for (int o = 32; o > 0; o >>= 1) v += __shfl_xor(v, o);
    return v;
}
__device__ __forceinline__ float rinv_of(float ss, float invn) { return rsqrtf(ss * invn + 1e-6f); }
typedef unsigned long long stat_t;
__device__ __forceinline__ float rinv_st(stat_t s, float invn) { return rsqrtf((float)((double)s * (1.0 / 4294967296.0)) * invn + 1e-6f); }
__device__ __forceinline__ void stat_add(stat_t* p, float ss) { __hip_atomic_fetch_add(p, (stat_t)((double)ss * 4294967296.0), __ATOMIC_RELAXED, __HIP_MEMORY_SCOPE_AGENT); }

__device__ __forceinline__ f32x2 gelu_pk(f32x2 v) {
    const f32x2 av = __builtin_elementwise_abs(v), d = av * 0.2316418882f + 1.0f;
    f32x2 t; t.x = __builtin_amdgcn_rcpf(d.x); t.y = __builtin_amdgcn_rcpf(d.y);
    f32x2 q = t * 0.5307027145f + (-0.7265760135f); q = q * t + 0.7107068705f; q = q * t + (-0.142248368f); q = q * t + 0.127414796f; q = q * t;
    const f32x2 s = (v * v) * (-0.72134752044f);
    f32x2 e; e.x = __builtin_amdgcn_exp2f(s.x); e.y = __builtin_amdgcn_exp2f(s.y);
    const f32x2 m = v * (q * e), r = v - m;
    f32x2 o; o.x = v.x < 0.f ? m.x : r.x; o.y = v.y < 0.f ? m.y : r.y; return o;
}

namespace pg8 {
constexpr int BM = 256, BK = 64, HALF = 128, HTB = HALF * BK * 2, STAGE_BYTES = 8 * HTB, NXCD = 8, WGM = 8;
__host__ __device__ __forceinline__ int lds_byte(int r, int c) { const int st = (r >> 4) * 2 + (c >> 5), rr = r & 15, cc = c & 31, ob = rr * 64 + cc * 2; return st * 1024 + (ob ^ (((ob >> 9) & 1) << 5)); }
__host__ __device__ __forceinline__ void stage_rc(int b, int& R, int& C) { const int st = b / 1024, sb = b % 1024, swz = sb ^ (((sb >> 9) & 1) << 5); R = (st >> 1) * 16 + swz / 64; C = (st & 1) * 32 + (swz % 64) / 2; }
__host__ __device__ __forceinline__ int perm32(int rho) { const int n = rho >> 4, i = rho & 15; return 8 * (i >> 2) + 4 * n + (i & 3); }

struct Unit { int pm, pn; };
struct Gemm { const bf16_t* A; const bf16_t* Bt; int M, N, K, lda, ldb; };

struct StaticOrder {
    int nM, nN, nwg, G, c;
    __device__ void init(int M, int N, int G_, int c_) { nM = M / BM; nN = N / BM; nwg = nM * nN; G = G_; c = c_; }
    __device__ bool next(int i, Unit& u) const {
        const long L = (long)i * G + c; if (L >= nwg) return false;
        int wgid = (int)L; { const int q = nwg / NXCD, r = nwg % NXCD, xcd = wgid % NXCD, off = wgid / NXCD; wgid = (xcd < r ? xcd * (q + 1) : r * (q + 1) + (xcd - r) * q) + off; }
        const int nig = WGM * nN, gid = wgid / nig, fm = gid * WGM, gsz = (nM - fm) < WGM ? (nM - fm) : WGM;
        u.pm = fm + ((wgid % nig) % gsz); u.pn = (wgid % nig) / gsz; return true;
    }
};

template <class Epi>
__device__ __forceinline__ void gemm_phase(const int TID, const int BID, LAS unsigned char* lds, const Gemm g, const StaticOrder& S, const Epi& E) {
    const int tid = TID, wid = __builtin_amdgcn_readfirstlane(tid >> 6), lane = tid & 63, wr = wid >> 2, wc = wid & 3, fr = lane & 15, fq = lane >> 4;
    const int K = g.K, nt = K / BK;
    unsigned voffA[2], voffB[2];
#pragma unroll
    for (int i = 0; i < 2; ++i) { int R, C; stage_rc(tid * 16 + i * 8192, R, C); const int Rb = Epi::PERM ? ((R & ~31) + perm32(R & 31)) : R;
        voffA[i] = (unsigned)(R * g.lda + C) * 2u; voffB[i] = (unsigned)(Rb * g.ldb + C) * 2u; }
    const size_t kstep = (size_t)(BK * 2);
    const size_t hstepA = (size_t)HALF * g.lda * 2, hstepB = (size_t)HALF * g.ldb * 2;
    const size_t tstepA = 2 * hstepA, tstepB = 2 * hstepB;
    const unsigned ldsw = (unsigned)wid * 1024u;
    const int aoff = lds_byte(wr * 64 + fr, fq * 8), boff = lds_byte(wc * 32 + fr, fq * 8);
#define PG8_SA(b, h) (((b) * 2 + (h)) * HTB)
#define PG8_SB(b, h) ((4 + (b) * 2 + (h)) * HTB)
#define PG8_STAGE(bufoff, gbase, voff) do { _Pragma("unroll") for (int _i = 0; _i < 2; ++_i) \
        __builtin_amdgcn_global_load_lds((const unsigned*)((const char*)(gbase) + (voff)[_i]), (LAS unsigned*)(lds + (bufoff) + ldsw + _i * 8192), 16, 0, 0); } while (0)
#define PG8_LDA(dst, b, h) do { _Pragma("unroll") for (int m = 0; m < 4; ++m) _Pragma("unroll") for (int k = 0; k < 2; ++k) dst[m][k] = *(const LAS bf16x8*)(lds + PG8_SA(b, h) + aoff + m * 2048 + k * 1024); } while (0)
#define PG8_LDB(dst, b, h) do { _Pragma("unroll") for (int n = 0; n < 2; ++n) _Pragma("unroll") for (int k = 0; k < 2; ++k) dst[n][k] = *(const LAS bf16x8*)(lds + PG8_SB(b, h) + boff + n * 2048 + k * 1024); } while (0)
#define PG8_MMA(ai, bj, At, Bt) do { __builtin_amdgcn_s_setprio(1); _Pragma("unroll") for (int m = 0; m < 4; ++m) _Pragma("unroll") for (int n = 0; n < 2; ++n) _Pragma("unroll") for (int k = 0; k < 2; ++k) \
        acc[ai][bj][m][n] = __builtin_amdgcn_mfma_f32_16x16x32_bf16(Bt[n][k], At[m][k], acc[ai][bj][m][n], 0, 0, 0); __builtin_amdgcn_s_setprio(0); } while (0)
#define PG8_WAIT_V(n) asm volatile("s_waitcnt vmcnt(" #n ")" ::: "memory")
#define PG8_WAIT_L(n) asm volatile("s_waitcnt lgkmcnt(" #n ")" ::: "memory")
#define PG8_BAR __builtin_amdgcn_s_barrier()
#define PG8_SCHED __builtin_amdgcn_sched_barrier(0)
    Unit cur, nxt; int ui = 0;
    if (!S.next(0, cur)) return;
    f32x4 acc[2][2][4][2];
#pragma unroll
    for (int a = 0; a < 2; ++a)
#pragma unroll
        for (int b = 0; b < 2; ++b)
#pragma unroll
            for (int m = 0; m < 4; ++m)
#pragma unroll
                for (int n = 0; n < 2; ++n) acc[a][b][m][n] = (f32x4){0.f, 0.f, 0.f, 0.f};
    bf16x8 At[4][2], B0[2][2], B1[2][2];
    const char* cA = (const char*)g.A + (size_t)cur.pm * tstepA; const char* cB = (const char*)g.Bt + (size_t)cur.pn * tstepB;
    PG8_STAGE(PG8_SB(0, 0), cB, voffB); PG8_STAGE(PG8_SA(0, 0), cA, voffA); PG8_STAGE(PG8_SB(0, 1), cB + hstepB, voffB); PG8_STAGE(PG8_SA(0, 1), cA + hstepA, voffA);
    if (wr == 1) PG8_BAR;
    PG8_WAIT_V(4); PG8_BAR;
    PG8_STAGE(PG8_SB(1, 0), cB + kstep, voffB); PG8_STAGE(PG8_SA(1, 0), cA + kstep, voffA); PG8_STAGE(PG8_SB(1, 1), cB + hstepB + kstep, voffB);
    PG8_WAIT_V(6); PG8_BAR;
    for (;;) {
        const bool has_next = S.next(ui + 1, nxt);
        const char* nA = has_next ? (const char*)g.A + (size_t)nxt.pm * tstepA : cA; const char* nB = has_next ? (const char*)g.Bt + (size_t)nxt.pn * tstepB : cB;
        for (int t = 0; t < nt; t += 2) {
            const bool last = (t == nt - 2);
            const char* a1 = cA + (size_t)(t + 1) * kstep;
            const char* a2 = last ? nA : cA + (size_t)(t + 2) * kstep; const char* b2 = last ? nB : cB + (size_t)(t + 2) * kstep;
            const char* a3 = a2 + kstep; const char* b3 = b2 + kstep;
            PG8_LDB(B0, 0, 0); PG8_SCHED; PG8_LDA(At, 0, 0); PG8_STAGE(PG8_SA(1, 1), a1 + hstepA, voffA);
            PG8_WAIT_L(8); PG8_BAR; PG8_WAIT_L(0); PG8_MMA(0, 0, At, B0); PG8_BAR; PG8_SCHED;
            PG8_LDB(B1, 0, 1); PG8_STAGE(PG8_SB(0, 0), b2, voffB);
            PG8_BAR; PG8_WAIT_L(0); PG8_MMA(0, 1, At, B1); PG8_BAR;
            PG8_LDA(At, 0, 1); PG8_STAGE(PG8_SA(0, 0), a2, voffA);
            PG8_BAR; PG8_WAIT_L(0); PG8_MMA(1, 0, At, B0); PG8_BAR; PG8_SCHED;
            PG8_STAGE(PG8_SB(0, 1), b2 + hstepB, voffB);
            PG8_WAIT_V(6); PG8_BAR; PG8_MMA(1, 1, At, B1); PG8_BAR;
            PG8_LDB(B0, 1, 0); PG8_SCHED; PG8_LDA(At, 1, 0); PG8_STAGE(PG8_SA(0, 1), a2 + hstepA, voffA);
            PG8_WAIT_L(8); PG8_BAR; PG8_WAIT_L(0); PG8_MMA(0, 0, At, B0); PG8_BAR; PG8_SCHED;
            PG8_LDB(B1, 1, 1); PG8_STAGE(PG8_SB(1, 0), b3, voffB);
            PG8_BAR; PG8_WAIT_L(0); PG8_MMA(0, 1, At, B1); PG8_BAR;
            PG8_LDA(At, 1, 1); PG8_STAGE(PG8_SA(1, 0), a3, voffA);
            PG8_BAR; PG8_WAIT_L(0); PG8_MMA(1, 0, At, B0); PG8_BAR; PG8_SCHED;
            PG8_STAGE(PG8_SB(1, 1), b3 + hstepB, voffB);
            PG8_WAIT_V(6); PG8_BAR; PG8_MMA(1, 1, At, B1); PG8_BAR;
        }
        E(acc, cur, wr, wc, fr, fq);
        if (!has_next) break;
#pragma unroll
        for (int a = 0; a < 2; ++a)
#pragma unroll
            for (int b = 0; b < 2; ++b)
#pragma unroll
                for (int m = 0; m < 4; ++m)
#pragma unroll
                    for (int n = 0; n < 2; ++n) acc[a][b][m][n] = (f32x4){0.f, 0.f, 0.f, 0.f};
        cur = nxt; cA = nA; cB = nB; ++ui;
    }
    PG8_WAIT_V(0);
    if (wr == 0) PG8_BAR;
    PG8_BAR;
#undef PG8_SA
#undef PG8_SB
#undef PG8_STAGE
#undef PG8_LDA
#undef PG8_LDB
#undef PG8_MMA
#undef PG8_WAIT_V
#undef PG8_WAIT_L
#undef PG8_BAR
#undef PG8_SCHED
}

struct EpiRes {
    static constexpr bool PERM = true;
    const float* srcf; const bf16_t* srcb; float* dstf; bf16_t* xb; const float* colscale; stat_t* stats; int col_off;
    __device__ __forceinline__ void operator()(const f32x4 (&acc)[2][2][4][2], const Unit& u, int wr, int wc, int fr, int fq) const {
        const int row0 = u.pm * BM + wr * 64 + fr, col0 = col_off + u.pn * BM + wc * 32 + 8 * fq;
        f32x4 cs[2][2];
#pragma unroll
        for (int bj = 0; bj < 2; ++bj)
#pragma unroll
            for (int n = 0; n < 2; ++n) cs[bj][n] = colscale ? *(const f32x4*)(colscale + col0 + bj * HALF + 4 * n) : (f32x4){1.f, 1.f, 1.f, 1.f};
#pragma unroll
        for (int ai = 0; ai < 2; ++ai)
#pragma unroll
            for (int m = 0; m < 4; ++m) {
                const int row = row0 + ai * HALF + m * 16; const size_t ro = (size_t)row * D + col0; float ss = 0.f;
#pragma unroll
                for (int bj = 0; bj < 2; ++bj) {
                    const size_t o = ro + bj * HALF;
                    f32x4 s0, s1;
                    if (srcf) { s0 = *(const f32x4*)(srcf + o); s1 = *(const f32x4*)(srcf + o + 4); }
                    else { const u32x4 w = *(const u32x4*)(srcb + o); s0 = (f32x4){bf_lo(w.x), bf_hi(w.x), bf_lo(w.y), bf_hi(w.y)}; s1 = (f32x4){bf_lo(w.z), bf_hi(w.z), bf_lo(w.w), bf_hi(w.w)}; }
                    const f32x4 v0 = acc[ai][bj][m][0] * cs[bj][0] + s0, v1 = acc[ai][bj][m][1] * cs[bj][1] + s1;
                    ss += v0[0] * v0[0] + v0[1] * v0[1] + v0[2] * v0[2] + v0[3] * v0[3] + v1[0] * v1[0] + v1[1] * v1[1] + v1[2] * v1[2] + v1[3] * v1[3];
                    if (dstf) { *(f32x4*)(dstf + o) = v0; *(f32x4*)(dstf + o + 4) = v1; }
                    if (xb) { u32x4 w; w.x = cvt_pk_bf16(v0[0], v0[1]); w.y = cvt_pk_bf16(v0[2], v0[3]); w.z = cvt_pk_bf16(v1[0], v1[1]); w.w = cvt_pk_bf16(v1[2], v1[3]); *(u32x4*)(xb + o) = w; }
                }
                if (stats) { ss += __shfl_xor(ss, 16); ss += __shfl_xor(ss, 32); if (fq == 0) stat_add(stats + row, ss); }
            }
    }
};
struct EpiUp {
    static constexpr bool PERM = true;
    bf16_t* U; const stat_t* stats;
    __device__ __forceinline__ void operator()(const f32x4 (&acc)[2][2][4][2], const Unit& u, int wr, int wc, int fr, int fq) const {
        const int row0 = u.pm * BM + wr * 64 + fr, col0 = u.pn * BM + wc * 32 + 8 * fq;
#pragma unroll
        for (int ai = 0; ai < 2; ++ai)
#pragma unroll
            for (int m = 0; m < 4; ++m) {
                const int row = row0 + ai * HALF + m * 16; const float r = rinv_st(stats[row], 1.0f / 2048.0f);
                bf16_t* rowp = U + (size_t)row * FF + col0;
#pragma unroll
                for (int bj = 0; bj < 2; ++bj) {
                    f32x4 v0 = acc[ai][bj][m][0] * r, v1 = acc[ai][bj][m][1] * r;
#pragma unroll
                    for (int j = 0; j < 4; ++j) { const float a = fmaxf(v0[j], 0.f), b = fmaxf(v1[j], 0.f); v0[j] = a * a; v1[j] = b * b; }
                    u32x4 w; w.x = cvt_pk_bf16(v0[0], v0[1]); w.y = cvt_pk_bf16(v0[2], v0[3]); w.z = cvt_pk_bf16(v1[0], v1[1]); w.w = cvt_pk_bf16(v1[2], v1[3]);
                    *(u32x4*)(rowp + bj * HALF) = w;
                }
            }
    }
};
struct EpiRaw {
    static constexpr bool PERM = true;
    bf16_t* raw; const stat_t* stats;
    __device__ __forceinline__ void operator()(const f32x4 (&acc)[2][2][4][2], const Unit& u, int wr, int wc, int fr, int fq) const {
        const int row0 = u.pm * BM + wr * 64 + fr, col0 = u.pn * BM + wc * 32 + 8 * fq;
#pragma unroll
        for (int ai = 0; ai < 2; ++ai)
#pragma unroll
            for (int m = 0; m < 4; ++m) {
                const int row = row0 + ai * HALF + m * 16; const float r = rinv_st(stats[row], 1.0f / 2048.0f);
                bf16_t* rowp = raw + (size_t)row * NINP + col0;
#pragma unroll
                for (int bj = 0; bj < 2; ++bj) {
                    const f32x4 v0 = acc[ai][bj][m][0] * r, v1 = acc[ai][bj][m][1] * r;
                    u32x4 w; w.x = cvt_pk_bf16(v0[0], v0[1]); w.y = cvt_pk_bf16(v0[2], v0[3]); w.z = cvt_pk_bf16(v1[0], v1[1]); w.w = cvt_pk_bf16(v1[2], v1[3]);
                    *(u32x4*)(rowp + bj * HALF) = w;
                }
            }
    }
};
struct EpiRawT {
    static constexpr bool PERM = false;
    float* raw; const stat_t* stats;
    __device__ __forceinline__ void operator()(const f32x4 (&acc)[2][2][4][2], const Unit& u, int wr, int wc, int fr, int fq) const {
        const int row0 = u.pm * BM + wr * 64 + fr, col0 = u.pn * BM + wc * 32 + 4 * fq;
#pragma unroll
        for (int ai = 0; ai < 2; ++ai)
#pragma unroll
            for (int m = 0; m < 4; ++m) {
                const int row = row0 + ai * HALF + m * 16; const float r = rinv_st(stats[row], 1.0f / 2048.0f);
                float* rowp = raw + (size_t)row * 256 + col0;
#pragma unroll
                for (int bj = 0; bj < 2; ++bj)
#pragma unroll
                    for (int n = 0; n < 2; ++n) *(f32x4*)(rowp + bj * HALF + n * 16) = acc[ai][bj][m][n] * r;
            }
    }
};
struct EpiSgu {
    static constexpr bool PERM = true;
    bf16_t* uv; const stat_t* stats; const float* bias; stat_t* stats_v;
    __device__ __forceinline__ void operator()(const f32x4 (&acc)[2][2][4][2], const Unit& u, int wr, int wc, int fr, int fq) const {
        const int row0 = u.pm * BM + wr * 64 + fr, col0 = u.pn * BM + wc * 32 + 8 * fq;
        f32x4 bv[2][2];
#pragma unroll
        for (int bj = 0; bj < 2; ++bj)
#pragma unroll
            for (int n = 0; n < 2; ++n) bv[bj][n] = *(const f32x4*)(bias + col0 + bj * HALF + 4 * n);
        const bool isv = u.pn >= 8;
#pragma unroll
        for (int ai = 0; ai < 2; ++ai)
#pragma unroll
            for (int m = 0; m < 4; ++m) {
                const int row = row0 + ai * HALF + m * 16; const float r = rinv_st(stats[row], 1.0f / 2048.0f);
                bf16_t* rowp = uv + (size_t)row * 4096 + col0; float ss = 0.f;
#pragma unroll
                for (int bj = 0; bj < 2; ++bj) {
                    const f32x4 v0 = acc[ai][bj][m][0] * r + bv[bj][0], v1 = acc[ai][bj][m][1] * r + bv[bj][1];
                    const f32x2 a = gelu_pk((f32x2){v0[0], v0[1]}), b = gelu_pk((f32x2){v0[2], v0[3]}), c = gelu_pk((f32x2){v1[0], v1[1]}), d = gelu_pk((f32x2){v1[2], v1[3]});
                    ss += a.x * a.x + a.y * a.y + b.x * b.x + b.y * b.y + c.x * c.x + c.y * c.y + d.x * d.x + d.y * d.y;
                    u32x4 w; w.x = cvt_pk_bf16(a.x, a.y); w.y = cvt_pk_bf16(b.x, b.y); w.z = cvt_pk_bf16(c.x, c.y); w.w = cvt_pk_bf16(d.x, d.y);
                    *(u32x4*)(rowp + bj * HALF) = w;
                }
                ss += __shfl_xor(ss, 16); ss += __shfl_xor(ss, 32);
                if (isv && fq == 0) stat_add(stats_v + row, ss);
            }
    }
};
}

#define CAS __attribute__((address_space(4)))
typedef const CAS Params* PP;
struct ConvDesc { const float* src; bf16_t* dst; int K, N, Npad; const float* ks; int ntiles; };
__device__ __forceinline__ ConvDesc conv_desc(PP p, int m) {
    ConvDesc d;
    if (m < 8) { d.src = p->pool_w + (size_t)m * 512 * 512; d.dst = (bf16_t*)(p->ws + WS_WPOOL) + (size_t)m * 512 * 512; d.K = 512; d.N = 512; d.Npad = 512; d.ks = nullptr; }
    else if (m == 8) { d.src = p->attn_w_in; d.dst = (bf16_t*)(p->ws + WS_WAIN); d.K = 2048; d.N = NIN; d.Npad = NINP; d.ks = p->norm_mix + 1 * D; }
    else if (m == 9) { d.src = p->attn_w_o; d.dst = (bf16_t*)(p->ws + WS_WAO); d.K = 2048; d.N = 2048; d.Npad = 2048; d.ks = nullptr; }
    else if (m == 10) { d.src = p->sgu_w_in; d.dst = (bf16_t*)(p->ws + WS_WSIN); d.K = 2048; d.N = 4096; d.Npad = 4096; d.ks = p->norm_mix + 2 * D; }
    else if (m == 11) { d.src = p->sgu_w_o; d.dst = (bf16_t*)(p->ws + WS_WSO); d.K = 2048; d.N = 2048; d.Npad = 2048; d.ks = nullptr; }
    else if (m < 16) { const int i = m - 12; d.src = p->ffn_w_up + (size_t)i * 2048 * 8192; d.dst = (bf16_t*)(p->ws + WS_WUP) + (size_t)i * 2048 * 8192; d.K = 2048; d.N = 8192; d.Npad = 8192; d.ks = p->norm_ffn + i * D; }
    else { const int i = m - 16; d.src = p->ffn_w_down + (size_t)i * 2048 * 8192; d.dst = (bf16_t*)(p->ws + WS_WDN) + (size_t)i * 2048 * 8192; d.K = 8192; d.N = 2048; d.Npad = 2048; d.ks = nullptr; }
    d.ntiles = (d.K / 64) * (d.Npad / 128);
    return d;
}

__device__ __forceinline__ void conv_load(const int TID, const ConvDesc& d, int tile, f32x4 (&a)[2][2]) {
    const int t = TID, nkb = d.K / 64, nb = tile / nkb, kb = tile % nkb;
#pragma unroll
    for (int i = 0; i < 2; ++i) {
        const int u = t + 512 * i, nq = (u & 15) + 16 * ((u >> 6) & 1), kp = ((u >> 4) & 3) + 4 * (u >> 7);
        const int k = kb * 64 + 2 * kp, n = nb * 128 + 4 * nq;
        if (n < d.N) { a[i][0] = *(const f32x4*)(d.src + (size_t)k * d.N + n); a[i][1] = *(const f32x4*)(d.src + (size_t)(k + 1) * d.N + n); }
        else { a[i][0] = (f32x4){0.f, 0.f, 0.f, 0.f}; a[i][1] = (f32x4){0.f, 0.f, 0.f, 0.f}; }
        if (d.ks) { a[i][0] *= d.ks[k]; a[i][1] *= d.ks[k + 1]; }
    }
}

__device__ __forceinline__ void conv_phase(const int TID, const int BID, PP p, LAS unsigned* ldsw) {
    const int t = TID, G = gridDim.x;
    int m = 0; ConvDesc d = conv_desc(p, 0); int base = 0;
    int total = 0;
    for (int i = 0; i < 20; ++i) total += conv_desc(p, i).ntiles;
    int gid = BID;
    f32x4 a[2][2];
    bool have = gid < total;
    if (have) { while (gid >= base + d.ntiles) { base += d.ntiles; ++m; d = conv_desc(p, m); } conv_load(TID, d, gid - base, a); }
    while (have) {
        const ConvDesc cd = d; const int ctile = gid - base;
        __syncthreads();
#pragma unroll
        for (int i = 0; i < 2; ++i) {
            const int u = t + 512 * i, nq = (u & 15) + 16 * ((u >> 6) & 1), kp = ((u >> 4) & 3) + 4 * (u >> 7);
#pragma unroll
            for (int e = 0; e < 4; ++e) ldsw[(4 * nq + e) * 33 + kp] = cvt_pk_bf16(a[i][0][e], a[i][1][e]);
        }
        gid += G; have = gid < total;
        if (have) { while (gid >= base + d.ntiles) { base += d.ntiles; ++m; d = conv_desc(p, m); } conv_load(TID, d, gid - base, a); }
        __syncthreads();
        {
            const int nkb = cd.K / 64, nb = ctile / nkb, kb = ctile % nkb, n = t >> 2, kc = t & 3;
            unsigned w[8];
#pragma unroll
            for (int j = 0; j < 8; ++j) w[j] = ldsw[n * 33 + kc * 8 + j];
            bf16_t* o = cd.dst + (size_t)(nb * 128 + n) * cd.K + kb * 64 + kc * 16;
            *(u32x4*)o = (u32x4){w[0], w[1], w[2], w[3]}; *(u32x4*)(o + 8) = (u32x4){w[4], w[5], w[6], w[7]};
        }
    }
    __syncthreads();
}

template <bool BF> __device__ __forceinline__ f32x4 ld4(const void* base, size_t idx) {
    if (BF) { const u32x2 w = *(const u32x2*)((const bf16_t*)base + idx); return (f32x4){bf_lo(w.x), bf_hi(w.x), bf_lo(w.y), bf_hi(w.y)}; }
    else return *(const f32x4*)((const float*)base + idx);
}
template <bool BF, int W> __device__ __forceinline__ void poolp_chunk(const void* xsrc, size_t xb0, int s_base, int s0, int c, f32x4 g4, const LAS float* rinv, bf16_t* Pout) {
    f32x4 h[W + 8];
#pragma unroll
    for (int r = 0; r < W + 8; ++r) {
        const int s = s_base - W + r;
        if (s >= 0) h[r] = ld4<BF>(xsrc, xb0 + (size_t)s * D + c) * (g4 * rinv[s - s0 + 16]);
        else h[r] = (f32x4){0.f, 0.f, 0.f, 0.f};
    }
    f32x4 S = (f32x4){0.f, 0.f, 0.f, 0.f};
#pragma unroll
    for (int i = 0; i < W; ++i) S += h[i];
#pragma unroll
    for (int tt = 0; tt < 8; ++tt) {
        const int s = s_base + tt;
        S += h[W + tt] - h[tt];
        const float inv = 1.0f / (float)min(s + 1, W);
        const f32x4 pv = S * inv - h[W + tt];
        u32x2 o; o.x = cvt_pk_bf16(pv[0], pv[1]); o.y = cvt_pk_bf16(pv[2], pv[3]);
        *(u32x2*)(Pout + (size_t)tt * D) = o;
    }
}
template <bool BF> __device__ __forceinline__ void poolp_phase(const int TID, const int BID, const void* xsrc, const float* gain, bf16_t* P, LAS float* ldsf, const stat_t* stats) {
    const int t = TID, wv = t >> 6, lane = t & 63;
    for (int item = BID; item < 256; item += gridDim.x) {
        const int tok0 = item * 32, b = tok0 >> 12, s0 = tok0 & 4095;
        const size_t xb0 = (size_t)b * SEQ * D;
        if (stats) {
            if (t < 48) { const int s = s0 - 16 + t; ldsf[t] = (s >= 0) ? rinv_st(stats[b * SEQ + s], 1.0f / 2048.0f) : 0.f; }
        } else {
#pragma unroll
            for (int half = 0; half < 2; ++half) {
                f32x4 v[3][8];
#pragma unroll
                for (int k = 0; k < 3; ++k) { const int s = s0 - 16 + wv + 8 * (3 * half + k);
#pragma unroll
                    for (int i = 0; i < 8; ++i) v[k][i] = (s >= 0) ? ld4<BF>(xsrc, xb0 + (size_t)s * D + 4 * (lane + 64 * i)) : (f32x4){0.f, 0.f, 0.f, 0.f}; }
#pragma unroll
                for (int k = 0; k < 3; ++k) { float ss = 0.f;
#pragma unroll
                    for (int i = 0; i < 8; ++i) ss += v[k][i][0] * v[k][i][0] + v[k][i][1] * v[k][i][1] + v[k][i][2] * v[k][i][2] + v[k][i][3] * v[k][i][3];
                    ss = wave_sum(ss);
                    if (lane == 0) ldsf[wv + 8 * (3 * half + k)] = rinv_of(ss, 1.0f / 2048.0f); }
            }
        }
        __syncthreads();
        const int c = 4 * t; const f32x4 g4 = *(const f32x4*)(gain + c);
        for (int ch = 0; ch < 4; ++ch) {
            bf16_t* Pout = P + (size_t)(tok0 + 8 * ch) * D + c;
            switch (t >> 7) {
                case 0: poolp_chunk<BF, 2>(xsrc, xb0, s0 + 8 * ch, s0, c, g4, ldsf, Pout); break;
                case 1: poolp_chunk<BF, 4>(xsrc, xb0, s0 + 8 * ch, s0, c, g4, ldsf, Pout); break;
                case 2: poolp_chunk<BF, 8>(xsrc, xb0, s0 + 8 * ch, s0, c, g4, ldsf, Pout); break;
                default: poolp_chunk<BF, 16>(xsrc, xb0, s0 + 8 * ch, s0, c, g4, ldsf, Pout); break;
            }
        }
        __syncthreads();
    }
}

__device__ __forceinline__ void rope_cs(int pos, float inv, float& c, float& s) {
    double rev = (double)pos * (double)inv * 0.15915494309189535; rev -= __builtin_rint(rev);
    const float f = (float)rev; s = __builtin_amdgcn_sinf(f); c = __builtin_amdgcn_cosf(f);
}
__device__ __forceinline__ void prep_phase(const int TID, const int BID, PP p) {
    const int lane = TID & 63, wg = BID * 8 + (TID >> 6), nw = gridDim.x * 8;
    const bf16_t* raw = (const bf16_t*)(p->ws + WS_BIG); const float* rawt = (const float*)(p->ws + WS_RAWT);
    bf16_t* Qb = (bf16_t*)(p->ws + WS_QB); bf16_t* Kb = (bf16_t*)(p->ws + WS_KB); bf16_t* Vb = (bf16_t*)(p->ws + WS_VB);
    bf16_t* QIb = (bf16_t*)(p->ws + WS_QIB); bf16_t* KIb = (bf16_t*)(p->ws + WS_KIB); float* WI = (float*)(p->ws + WS_WI);
    const float L2T = 18.931568569324174f;
    for (int tok = wg; tok < T; tok += nw) {
        const bf16_t* r = raw + (size_t)tok * NINP; const int pos = tok & 4095;
        float cq[4], sq[4], ci[4], si[4];
        { const int j = lane & 3, ji = lane & 1;
#pragma unroll
          for (int e = 0; e < 4; ++e) {
              rope_cs(pos, exp2f(-(float)(4 * j + e) * (L2T / 16.0f)), cq[e], sq[e]);
              rope_cs(pos, exp2f(-(float)(4 * ji + e) * (L2T / 8.0f)), ci[e], si[e]); } }
#pragma unroll
        for (int it = 0; it < 10; ++it) {
            const int head = 2 * it + (lane >> 5), j = lane & 31;
            const bool isq = head < 16;
            const int col = isq ? head * 128 : 2048 + (head - 16) * 128;
            const u32x2 rw = *(const u32x2*)(r + col + 4 * j);
            f32x4 v = (f32x4){bf_lo(rw.x), bf_hi(rw.x), bf_lo(rw.y), bf_hi(rw.y)};
            float ss = v[0] * v[0] + v[1] * v[1] + v[2] * v[2] + v[3] * v[3];
#pragma unroll
            for (int o = 16; o > 0; o >>= 1) ss += __shfl_xor(ss, o);
            const float rn = rinv_of(ss, 1.0f / 128.0f);
            const f32x4 g4 = *(const f32x4*)((isq ? p->attn_q_gain : p->attn_k_gain) + 4 * j);
            v = v * rn * g4;
            f32x4 pt;
#pragma unroll
            for (int e = 0; e < 4; ++e) pt[e] = __shfl_xor(v[e], 4);
            if (j < 8) {
#pragma unroll
                for (int e = 0; e < 4; ++e) v[e] = (j < 4) ? v[e] * cq[e] - pt[e] * sq[e] : v[e] * cq[e] + pt[e] * sq[e];
            }
            u32x2 o; o.x = cvt_pk_bf16(v[0], v[1]); o.y = cvt_pk_bf16(v[2], v[3]);
            { int w8 = __builtin_amdgcn_cvt_pk_fp8_f32(v[0], v[1], 0, false); w8 = __builtin_amdgcn_cvt_pk_fp8_f32(v[2], v[3], w8, true);
              if (isq) *(int*)((unsigned char*)Qb + (size_t)tok * 2048 + head * 128 + 4 * j) = w8;
              else *(int*)((unsigned char*)Kb + (size_t)tok * 512 + (head - 16) * 128 + 4 * j) = w8; }
        }
        { const u32x4 vw = *(const u32x4*)(r + 2560 + 8 * lane);
          int lo = __builtin_amdgcn_cvt_pk_fp8_f32(bf_lo(vw.x), bf_hi(vw.x), 0, false); lo = __builtin_amdgcn_cvt_pk_fp8_f32(bf_lo(vw.y), bf_hi(vw.y), lo, true);
          int hi = __builtin_amdgcn_cvt_pk_fp8_f32(bf_lo(vw.z), bf_hi(vw.z), 0, false); hi = __builtin_amdgcn_cvt_pk_fp8_f32(bf_lo(vw.w), bf_hi(vw.w), hi, true);
          *(u32x2*)((unsigned char*)Vb + (size_t)tok * 512 + 8 * lane) = (u32x2){(unsigned)lo, (unsigned)hi}; }
#pragma unroll
        for (int it = 0; it < 5; ++it) {
            const int j = lane & 15;
            const int head = 4 * it + (lane >> 4);
            const int col = (it < 4) ? 3072 + head * 64 : 4096;
            f32x4 v;
            if (it < 4) { const u32x2 rw = *(const u32x2*)(r + col + 4 * j); v = (f32x4){bf_lo(rw.x), bf_hi(rw.x), bf_lo(rw.y), bf_hi(rw.y)}; }
            else { const float* rt = rawt + (size_t)tok * 256 + 4 * j; v = *(const f32x4*)rt + *(const f32x4*)(rt + (size_t)T * 256) + *(const f32x4*)(rt + (size_t)2 * T * 256) + *(const f32x4*)(rt + (size_t)3 * T * 256); }
            f32x4 pt;
#pragma unroll
            for (int e = 0; e < 4; ++e) pt[e] = __shfl_xor(v[e], 2);
            if (j < 4) {
#pragma unroll
                for (int e = 0; e < 4; ++e) v[e] = (j < 2) ? v[e] * ci[e] - pt[e] * si[e] : v[e] * ci[e] + pt[e] * si[e];
            }
            u32x2 o; o.x = cvt_pk_bf16(v[0], v[1]); o.y = cvt_pk_bf16(v[2], v[3]);
            if (it < 4) *(u32x2*)(QIb + (size_t)tok * 1024 + head * 64 + 4 * j) = o;
            else if (lane < 16) *(u32x2*)(KIb + (size_t)tok * 64 + 4 * j) = o;
        }
        if (lane < 16) { const float* rt = rawt + (size_t)tok * 256 + 64 + lane; WI[(size_t)tok * 16 + lane] = (rt[0] + rt[(size_t)T * 256] + rt[(size_t)2 * T * 256] + rt[(size_t)3 * T * 256]) * 0.03125f; }
    }
}

__device__ __forceinline__ void idx_phase(const int TID, const int BID, PP p, LAS unsigned char* lds) {
    const int t = TID, lane = t & 63, wv = t >> 6;
    const bf16_t* QIb = (const bf16_t*)(p->ws + WS_QIB); const bf16_t* KIb = (const bf16_t*)(p->ws + WS_KIB); const float* WI = (const float*)(p->ws + WS_WI);
    _Float16* Sc = (_Float16*)(p->ws + WS_BIG);
    const int rr = lane & 31, g2 = lane >> 5;
    for (int item = BID; item < 1088; item += gridDim.x) {
        const int b = item / 544; int rem = item % 544;
        int a = 0; while (rem >= 4 * (a + 1)) { rem -= 4 * (a + 1); ++a; }
        const int c = 4 * a + rem / (a + 1), kb = rem % (a + 1);
        const int key0 = kb * 256, Nk = (c + 1) * 64, nkeys = min(256, Nk - key0);
        __syncthreads();
        { const int key = t >> 1, half = t & 1;
          if (key < nkeys) { const bf16_t* src = KIb + (size_t)(b * SEQ + key0 + key) * 64 + half * 32;
#pragma unroll
              for (int j = 0; j < 4; ++j) *(LAS u32x4*)(lds + key * 144 + half * 64 + j * 16) = *(const u32x4*)(src + j * 8); } }
        __syncthreads();
        for (int pr = 0; pr < 4; ++pr) {
            const int tokq = b * SEQ + c * 64 + wv * 8 + 2 * pr;
            bf16x8 A[4]; float wq[16];
            { const bf16_t* src = QIb + (size_t)(tokq + (rr >> 4)) * 1024 + (rr & 15) * 64 + g2 * 32;
#pragma unroll
              for (int ks = 0; ks < 4; ++ks) A[ks] = *(const bf16x8*)(src + ks * 8); }
#pragma unroll
            for (int i = 0; i < 16; ++i) wq[i] = WI[(size_t)(tokq + (i >> 3)) * 16 + 8 * ((i >> 2) & 1) + 4 * g2 + (i & 3)];
            for (int kt = 0; kt < nkeys / 32; kt += 2) {
                f32x16 acc0, acc1;
#pragma unroll
                for (int i = 0; i < 16; ++i) { acc0[i] = 0.f; acc1[i] = 0.f; }
                bf16x8 Bf0[4], Bf1[4];
#pragma unroll
                for (int ks = 0; ks < 4; ++ks) { Bf0[ks] = *(const LAS bf16x8*)(lds + (kt * 32 + rr) * 144 + g2 * 64 + ks * 16); Bf1[ks] = *(const LAS bf16x8*)(lds + ((kt + 1) * 32 + rr) * 144 + g2 * 64 + ks * 16); }
#pragma unroll
                for (int ks = 0; ks < 4; ++ks) { acc0 = __builtin_amdgcn_mfma_f32_32x32x16_bf16(A[ks], Bf0[ks], acc0, 0, 0, 0); acc1 = __builtin_amdgcn_mfma_f32_32x32x16_bf16(A[ks], Bf1[ks], acc1, 0, 0, 0); }
                float s0 = 0.f, s1 = 0.f, t0 = 0.f, t1 = 0.f;
#pragma unroll
                for (int i = 0; i < 8; ++i) { s0 += fmaxf(acc0[i], 0.f) * wq[i]; s1 += fmaxf(acc0[8 + i], 0.f) * wq[8 + i]; t0 += fmaxf(acc1[i], 0.f) * wq[i]; t1 += fmaxf(acc1[8 + i], 0.f) * wq[8 + i]; }
                s0 += __shfl_xor(s0, 32); s1 += __shfl_xor(s1, 32); t0 += __shfl_xor(t0, 32); t1 += __shfl_xor(t1, 32);
                _Float16* so = Sc + (size_t)(tokq + g2) * SEQ + key0 + kt * 32 + rr;
                so[0] = (_Float16)(g2 ? s1 : s0); so[32] = (_Float16)(g2 ? t1 : t0);
            }
        }
    }
}

__device__ __forceinline__ unsigned fkey(float f) { const unsigned u = __float_as_uint(f); return (u & 0x80000000u) ? ~u : (u | 0x80000000u); }

__device__ __forceinline__ void attn_phase(const int TID, const int BID, PP p, LAS unsigned char* lds) {
    const int lane = TID & 63, wv = __builtin_amdgcn_readfirstlane(TID >> 6), wg = BID * 8 + wv, nw = gridDim.x * 8;
    const _Float16* Sc = (const _Float16*)(p->ws + WS_BIG);
    const bf16_t* Qb = (const bf16_t*)(p->ws + WS_QB); const bf16_t* Kb = (const bf16_t*)(p->ws + WS_KB); const bf16_t* Vb = (const bf16_t*)(p->ws + WS_VB);
    bf16_t* O = (bf16_t*)(p->ws + WS_AB);
    LAS unsigned short* widx = (LAS unsigned short*)(lds + wv * 512);
    LAS unsigned char* vt = lds + 4096 + wv * 16384;
    const int fr = lane & 15, fq = lane >> 4;
    for (int tok = wg; tok < T; tok += nw) {
        const int b = tok >> 12, s = tok & 4095, Nk = ((s >> 6) + 1) * 64, nsel = min(Nk, 256);
        if (Nk <= 256) {
#pragma unroll
            for (int i = 0; i < 4; ++i) { const int slot = lane + 64 * i; if (slot < Nk) widx[slot] = slot; }
        } else {
            unsigned key[64];
            int ln = lane; asm volatile("" : "+v"(ln));
            const _Float16* srow = Sc + (size_t)tok * SEQ;
#pragma unroll
            for (int i = 0; i < 16; ++i) {
                const int k0 = i * 256 + 4 * ln;
                if (k0 < Nk) { typedef _Float16 h16x4 __attribute__((ext_vector_type(4))); const h16x4 hv = *(const h16x4*)(srow + k0); const f32x4 v = (f32x4){(float)hv[0], (float)hv[1], (float)hv[2], (float)hv[3]};
#pragma unroll
                    for (int e = 0; e < 4; ++e) key[4 * i + e] = fkey(v[e]); }
                else {
#pragma unroll
                    for (int e = 0; e < 4; ++e) key[4 * i + e] = 0u; }
            }
            const int nib = (Nk + 255) >> 8;
            unsigned Tt = 0u;
            for (int bit = 31; bit >= 0; --bit) {
                const unsigned cand = Tt | (1u << bit);
                int c = 0;
#pragma unroll
                for (int ib = 0; ib < 16; ++ib)
                    if (ib < nib) {
#pragma unroll
                        for (int e = 0; e < 4; ++e) c += (key[4 * ib + e] >= cand) ? 1 : 0;
                    }
                int cnt = 0;
#pragma unroll
                for (int bp = 0; bp < 7; ++bp) cnt += __popcll(__ballot((c >> bp) & 1)) << bp;
                if (cnt >= 256) { Tt = cand; if (cnt == 256) break; }
            }
            int cnt_gt = 0;
#pragma unroll
            for (int ib = 0; ib < 16; ++ib)
                if (ib < nib) {
#pragma unroll
                    for (int e = 0; e < 4; ++e) cnt_gt += __popcll(__ballot(key[4 * ib + e] > Tt));
                }
            const int need = 256 - cnt_gt;
            int base = 0, tbase = 0;
#pragma unroll
            for (int j = 0; j < 64; ++j) if ((j >> 2) < nib) {
                const int kidx = (j >> 2) * 256 + 4 * ln + (j & 3);
                const bool gt = key[j] > Tt; const unsigned long long m1 = __ballot(gt);
                const int pre = __builtin_amdgcn_mbcnt_hi((unsigned)(m1 >> 32), __builtin_amdgcn_mbcnt_lo((unsigned)m1, 0));
                if (gt) widx[base + pre] = kidx;
                base += __popcll(m1);
                const bool eq = key[j] == Tt; const unsigned long long m2 = __ballot(eq);
                if (m2) {
                    const int pre2 = __builtin_amdgcn_mbcnt_hi((unsigned)(m2 >> 32), __builtin_amdgcn_mbcnt_lo((unsigned)m2, 0));
                    if (eq && tbase + pre2 < need) widx[cnt_gt + tbase + pre2] = kidx;
                    tbase += __popcll(m2);
                }
            }
        }
        __builtin_amdgcn_wave_barrier();
        asm volatile("s_waitcnt lgkmcnt(0)" ::: "memory");
        const bf16_t* Kbase = Kb + (size_t)(b * SEQ) * 512; const bf16_t* Vbase = Vb + (size_t)(b * SEQ) * 512;
        const int nblk = nsel >> 6;
        for (int g = 0; g < 4; ++g) {
            f32x4 sc[16];
            {
                long q8[4];
                { const unsigned char* qp = (const unsigned char*)Qb + (size_t)tok * 2048 + (g * 4 + (lane & 3)) * 128 + fq * 8;
#pragma unroll
                  for (int ks = 0; ks < 4; ++ks) q8[ks] = *(const long*)(qp + ks * 32); }
                u32x4 R[3][4];
                const unsigned char* kg = (const unsigned char*)Kb + (size_t)(b * SEQ) * 512 + g * 128 + (lane & 7) * 16;
                LAS unsigned char* ktw = vt + (lane >> 3) * 144 + (lane & 7) * 16;
                const LAS unsigned char* ktr = vt + fr * 144 + fq * 8;
                const int nst = nsel >> 5;
#define QK_LOAD(set, st) do { _Pragma("unroll") for (int i = 0; i < 4; ++i) { const int row = widx[(st) * 32 + i * 8 + (lane >> 3)] & 4095; R[set][i] = *(const u32x4*)(kg + (size_t)row * 512); } __builtin_amdgcn_sched_barrier(0); } while (0)
#define QK_STEP(set, st, more) do { \
                _Pragma("unroll") for (int i = 0; i < 4; ++i) *(LAS u32x4*)(ktw + i * 8 * 144) = R[set][i]; \
                __builtin_amdgcn_sched_barrier(0); \
                if (more) QK_LOAD(set, (st) + 3); \
                if ((st) < nst) { long af[2][4]; \
                    _Pragma("unroll") for (int tt = 0; tt < 2; ++tt) _Pragma("unroll") for (int ks = 0; ks < 4; ++ks) af[tt][ks] = *(const LAS long*)(ktr + tt * 16 * 144 + ks * 32); \
                    f32x4 a0 = (f32x4){0.f, 0.f, 0.f, 0.f}, a1 = a0, a2 = a0, a3 = a0;        \
                    a0 = __builtin_amdgcn_mfma_f32_16x16x32_fp8_fp8(af[0][0], q8[0], a0, 0, 0, 0); a1 = __builtin_amdgcn_mfma_f32_16x16x32_fp8_fp8(af[1][0], q8[0], a1, 0, 0, 0); \
                    a2 = __builtin_amdgcn_mfma_f32_16x16x32_fp8_fp8(af[0][2], q8[2], a2, 0, 0, 0); a3 = __builtin_amdgcn_mfma_f32_16x16x32_fp8_fp8(af[1][2], q8[2], a3, 0, 0, 0); \
                    a0 = __builtin_amdgcn_mfma_f32_16x16x32_fp8_fp8(af[0][1], q8[1], a0, 0, 0, 0); a1 = __builtin_amdgcn_mfma_f32_16x16x32_fp8_fp8(af[1][1], q8[1], a1, 0, 0, 0); \
                    a2 = __builtin_amdgcn_mfma_f32_16x16x32_fp8_fp8(af[0][3], q8[3], a2, 0, 0, 0); a3 = __builtin_amdgcn_mfma_f32_16x16x32_fp8_fp8(af[1][3], q8[3], a3, 0, 0, 0); \
                    sc[(st) * 2] = a0 + a2; sc[(st) * 2 + 1] = a1 + a3; } \
                else { sc[(st) * 2] = (f32x4){-INFINITY, -INFINITY, -INFINITY, -INFINITY}; sc[(st) * 2 + 1] = (f32x4){-INFINITY, -INFINITY, -INFINITY, -INFINITY}; } \
                __builtin_amdgcn_sched_barrier(0); } while (0)
                QK_LOAD(0, 0); QK_LOAD(1, 1); QK_LOAD(2, 2);
                QK_STEP(0, 0, true); QK_STEP(1, 1, true); QK_STEP(2, 2, true); QK_STEP(0, 3, true); QK_STEP(1, 4, true);
                QK_STEP(2, 5, false); QK_STEP(0, 6, false); QK_STEP(1, 7, false);
#undef QK_LOAD
#undef QK_STEP
            }
            float mx = -INFINITY;
#pragma unroll
            for (int kt = 0; kt < 16; ++kt)
#pragma unroll
                for (int i = 0; i < 4; ++i) mx = fmaxf(mx, sc[kt][i]);
            mx = fmaxf(mx, __shfl_xor(mx, 16)); mx = fmaxf(mx, __shfl_xor(mx, 32));
            const float sl2 = 0.08838834764831845f * 1.4426950408889634f;
            float sum = 0.f; const float nmxs = -mx * sl2;
#pragma unroll
            for (int kt = 0; kt < 16; ++kt)
#pragma unroll
                for (int i = 0; i < 4; ++i) { const float e = __builtin_amdgcn_exp2f(fmaf(sc[kt][i], sl2, nmxs)); sc[kt][i] = e; sum += e; }
            sum += __shfl_xor(sum, 16); sum += __shfl_xor(sum, 32);
            const float inv = 1.0f / sum;
            float invh[4];
#pragma unroll
            for (int i = 0; i < 4; ++i) invh[i] = __shfl(inv, i);
            long Af[8];
#pragma unroll
            for (int s2 = 0; s2 < 8; ++s2) {
                int lo = __builtin_amdgcn_cvt_pk_fp8_f32(sc[2 * s2][0], sc[2 * s2][1], 0, false); lo = __builtin_amdgcn_cvt_pk_fp8_f32(sc[2 * s2][2], sc[2 * s2][3], lo, true);
                int hi = __builtin_amdgcn_cvt_pk_fp8_f32(sc[2 * s2 + 1][0], sc[2 * s2 + 1][1], 0, false); hi = __builtin_amdgcn_cvt_pk_fp8_f32(sc[2 * s2 + 1][2], sc[2 * s2 + 1][3], hi, true);
                Af[s2] = (long)(((unsigned long long)(unsigned)hi << 32) | (unsigned)lo);
            }
            f32x4 acc[8];
#pragma unroll
            for (int nt = 0; nt < 8; ++nt) acc[nt] = (f32x4){0.f, 0.f, 0.f, 0.f};
            u32x4 R[3][4];
            const unsigned char* vg = (const unsigned char*)Vb + (size_t)(b * SEQ) * 512 + g * 128 + (lane & 7) * 16;
            LAS unsigned char* vtw = vt + (lane >> 3) * 144 + (lane & 7) * 16;
            const int rho0 = lane >> 3;
            const int slot0 = 16 * (rho0 >> 2) + (rho0 & 3);
            const unsigned trb = (unsigned)(size_t)(vt + (fq * 8 + (fr >> 1)) * 144 + (fr & 1) * 8);
#define PV_LOAD(set, st) do { _Pragma("unroll") for (int i = 0; i < 4; ++i) { const int row = widx[(st) * 32 + slot0 + 4 * i] & 4095; R[set][i] = *(const u32x4*)(vg + (size_t)row * 512); } __builtin_amdgcn_sched_barrier(0); } while (0)
#define PV_TR(dst, off) asm volatile("ds_read_b64_tr_b8 %0, %1 offset:" #off : "=v"(dst) : "v"(trb) : "memory")
#define PV_STEP(set, st, more) do { \
                _Pragma("unroll") for (int i = 0; i < 4; ++i) *(LAS u32x4*)(vtw + i * 8 * 144) = R[set][i]; \
                __builtin_amdgcn_sched_barrier(0); \
                if (more) PV_LOAD(set, (st) + 3); \
                u32x2 b0[8]; \
                PV_TR(b0[0], 0); PV_TR(b0[1], 16); PV_TR(b0[2], 32); PV_TR(b0[3], 48); PV_TR(b0[4], 64); PV_TR(b0[5], 80); PV_TR(b0[6], 96); PV_TR(b0[7], 112); \
                asm volatile("s_waitcnt lgkmcnt(0)" : "+v"(b0[0]), "+v"(b0[1]), "+v"(b0[2]), "+v"(b0[3]), "+v"(b0[4]), "+v"(b0[5]), "+v"(b0[6]), "+v"(b0[7]) :: "memory"); \
                _Pragma("unroll") for (int nt = 0; nt < 8; ++nt) \
                    acc[nt] = __builtin_amdgcn_mfma_f32_16x16x32_fp8_fp8(Af[st], __builtin_bit_cast(long, b0[nt]), acc[nt], 0, 0, 0); \
                __builtin_amdgcn_sched_barrier(0); } while (0)
            PV_LOAD(0, 0); PV_LOAD(1, 1); PV_LOAD(2, 2);
            PV_STEP(0, 0, true); PV_STEP(1, 1, true); PV_STEP(2, 2, true); PV_STEP(0, 3, true); PV_STEP(1, 4, true);
            PV_STEP(2, 5, false); PV_STEP(0, 6, false); PV_STEP(1, 7, false);
#undef PV_LOAD
#undef PV_TR
#undef PV_STEP
#pragma unroll
            for (int nt = 0; nt < 8; ++nt)
                if ((nt >> 1) == fq) {
#pragma unroll
                    for (int i = 0; i < 4; ++i) O[(size_t)tok * 2048 + (g * 4 + i) * 128 + nt * 16 + fr] = (bf16_t)(cvt_pk_bf16(acc[nt][i] * invh[i], 0.f) & 0xffffu);
                }
        }
        __builtin_amdgcn_wave_barrier();
    }
}

__device__ __forceinline__ void mix_phase(const int TID, const int BID, PP p, LAS unsigned char* lds) {
    const int t = TID, lane = t & 63, wv = t >> 6;
    const bf16_t* uv = (const bf16_t*)(p->ws + WS_BIG); const stat_t* stats_v = (const stat_t*)(p->ws + WS_STATS) + 4 * T;
    bf16_t* AB = (bf16_t*)(p->ws + WS_AB);
    LAS float* rinv = (LAS float*)lds; LAS unsigned char* Wsl = lds + 1024; LAS unsigned char* Vt = lds + 1024 + 128 * 272;
    const int rr = lane & 31, g2 = lane >> 5, it_ = wv & 3, ch = wv >> 2;
    for (int item = BID; item < 512; item += gridDim.x) {
        const int n = item >> 3, g = item & 7;
        __syncthreads();
        if (t < 128) rinv[t] = rinv_st(stats_v[n * 128 + t], 1.0f / 2048.0f);
        __syncthreads();
        { const int i = t >> 2, jseg = (t & 3) * 32; const float* wsrc = p->sgu_w_s + ((size_t)g * 128 + i) * 128 + jseg;
#pragma unroll
          for (int q = 0; q < 4; ++q) {
              f32x4 a = *(const f32x4*)(wsrc + q * 8), bq = *(const f32x4*)(wsrc + q * 8 + 4);
              const int j0 = jseg + q * 8; const bool ok = (j0 >> 6) <= (i >> 6);
              u32x4 w;
              if (ok) { w.x = cvt_pk_bf16(a[0] * rinv[j0], a[1] * rinv[j0 + 1]); w.y = cvt_pk_bf16(a[2] * rinv[j0 + 2], a[3] * rinv[j0 + 3]);
                        w.z = cvt_pk_bf16(bq[0] * rinv[j0 + 4], bq[1] * rinv[j0 + 5]); w.w = cvt_pk_bf16(bq[2] * rinv[j0 + 6], bq[3] * rinv[j0 + 7]); }
              else w = (u32x4){0u, 0u, 0u, 0u};
              *(LAS u32x4*)(Wsl + i * 272 + j0 * 2) = w;
          } }
        { const int j = t & 127, cgp = t >> 7; const bf16_t* vsrc = uv + (size_t)(n * 128 + j) * 4096 + 2048 + g * 256;
#pragma unroll
          for (int q = 0; q < 8; ++q) {
              const int c = (q * 4 + cgp) * 8; const u32x4 v = *(const u32x4*)(vsrc + c);
#pragma unroll
              for (int e = 0; e < 4; ++e) { *(LAS bf16_t*)(Vt + (c + 2 * e) * 272 + j * 2) = (bf16_t)(v[e] & 0xffffu); *(LAS bf16_t*)(Vt + (c + 2 * e + 1) * 272 + j * 2) = (bf16_t)(v[e] >> 16); }
          } }
        __syncthreads();
        f32x16 acc[4];
#pragma unroll
        for (int ct = 0; ct < 4; ++ct)
#pragma unroll
            for (int i = 0; i < 16; ++i) acc[ct][i] = 0.f;
#pragma unroll
        for (int ks = 0; ks < 8; ++ks) {
            const bf16x8 Af = *(const LAS bf16x8*)(Wsl + (it_ * 32 + rr) * 272 + (ks * 16 + g2 * 8) * 2);
#pragma unroll
            for (int ct = 0; ct < 4; ++ct) { const bf16x8 Bf = *(const LAS bf16x8*)(Vt + (ch * 128 + ct * 32 + rr) * 272 + (ks * 16 + g2 * 8) * 2); acc[ct] = __builtin_amdgcn_mfma_f32_32x32x16_bf16(Af, Bf, acc[ct], 0, 0, 0); }
        }
#pragma unroll
        for (int ct = 0; ct < 4; ++ct) {
            const int cg_ = g * 256 + ch * 128 + ct * 32 + rr; const float gain = p->sgu_v_gain[cg_];
#pragma unroll
            for (int r = 0; r < 16; ++r) {
                const int i = it_ * 32 + (r & 3) + 8 * (r >> 2) + 4 * g2; const size_t tok = (size_t)n * 128 + i;
                const float mixed = gain * acc[ct][r] + p->sgu_b_s[g * 128 + i];
                const float uval = __uint_as_float((unsigned)uv[tok * 4096 + cg_] << 16);
                AB[tok * 2048 + cg_] = (bf16_t)(cvt_pk_bf16(uval * mixed, 0.f) & 0xffffu);
            }
        }
    }
}

#define XB_TMO      128
#define XB_XCNT(j)  (256  + 64 * (j))
#define XB_XSUB(j)  (1280 + 64 * (j))
#define XB_XGEN(j)  (2304 + 64 * (j))
#define XB_TOP      3328
#define XB_TOPGEN   3392
#define XCD_BAR_WORDS 3456
#define XB_SPIN_CAP (1u << 22)
__device__ __forceinline__ unsigned xb_ld(unsigned* p)              { return __hip_atomic_load(p, __ATOMIC_RELAXED, __HIP_MEMORY_SCOPE_AGENT); }
__device__ __forceinline__ unsigned xb_add(unsigned* p, unsigned v) { return __hip_atomic_fetch_add(p, v, __ATOMIC_RELAXED, __HIP_MEMORY_SCOPE_AGENT); }
__device__ __forceinline__ unsigned xb_xcc_id() { return (unsigned)__builtin_amdgcn_s_getreg((3 << 11) | 20) & 0xFu; }
#define XB_SPIN(cond, bar) do { unsigned _sp = 0; while (cond) { __builtin_amdgcn_s_sleep(1); \
    if ((++_sp & 255u) == 0u) { if (xb_ld(&(bar)[XB_TMO])) break; if (_sp > XB_SPIN_CAP) { atomicAdd(&(bar)[XB_TMO], 1u); break; } } } } while (0)
__device__ __forceinline__ void xcd_barrier_complete(unsigned* bar, unsigned x, unsigned& nloc, unsigned& nx) {
    const unsigned G = gridDim.x * gridDim.y * gridDim.z;
    unsigned sum, cnt, mine, sp = 0u;
    for (;;) {
        sum = 0u; cnt = 0u; mine = 0u;
#pragma unroll
        for (unsigned j = 0; j < 16; ++j) { const unsigned c = xb_ld(&bar[XB_XCNT(j)]); sum += c; cnt += (c > 0u) ? 1u : 0u; mine = (j == x) ? c : mine; }
        if (sum == G) break;
        __builtin_amdgcn_s_sleep(1);
        if ((++sp & 255u) == 0u) { if (xb_ld(&bar[XB_TMO])) break; if (sp > XB_SPIN_CAP) { atomicAdd(&bar[XB_TMO], 1u); break; } }
    }
    nloc = mine > 0u ? mine : 1u; nx = cnt > 0u ? cnt : 1u;
}
__device__ __forceinline__ void xcd_barrier(unsigned* bar, volatile LAS unsigned* st) {
    asm volatile("s_waitcnt vmcnt(0)" ::: "memory");
    __syncthreads();
    if (threadIdx.x == 0) {
        const unsigned x = xb_xcc_id();
        __builtin_amdgcn_s_waitcnt(0);
        unsigned nloc = st[0], nx = st[1];
        if (nloc == 0u) { xcd_barrier_complete(bar, x, nloc, nx); st[0] = nloc; st[1] = nx; }
        const unsigned old = xb_add(&bar[XB_XSUB(x)], 1u);
        const unsigned gen = old / nloc;
        if (old + 1u == (gen + 1u) * nloc) {
            __builtin_amdgcn_fence(__ATOMIC_RELEASE, "agent");
            asm volatile("s_waitcnt vmcnt(0)" ::: "memory");
            const unsigned og = xb_add(&bar[XB_TOP], 1u);
            const unsigned tg = og / nx;
            if (og + 1u == (tg + 1u) * nx) xb_add(&bar[XB_TOPGEN], 1u);
            else XB_SPIN(xb_ld(&bar[XB_TOPGEN]) == tg, bar);
            __builtin_amdgcn_fence(__ATOMIC_ACQUIRE, "agent");
            xb_add(&bar[XB_XGEN(x)], 1u);
            asm volatile("s_waitcnt vmcnt(0)" ::: "memory");
        } else {
            XB_SPIN(xb_ld(&bar[XB_XGEN(x)]) == gen, bar);
            __builtin_amdgcn_fence(__ATOMIC_ACQUIRE, "agent");
            asm volatile("s_waitcnt vmcnt(0)" ::: "memory");
        }
    }
    __syncthreads();
}

__global__ __launch_bounds__(512, 2) void mega(Params p_) {
    extern __shared__ __attribute__((aligned(16))) unsigned char shm[];
    cg::grid_group grid = cg::this_grid();
    const int ph_lo = p_.phase_lo, ph_hi = p_.phase_hi;
    {
        volatile LAS unsigned* st0 = (volatile LAS unsigned*)((LAS unsigned char*)shm + LDS_BYTES);
        if (threadIdx.x == 0) { st0[0] = 0u; st0[1] = 0u; (void)xb_add(&((unsigned*)(p_.ws + WS_BAR))[XB_XCNT(xb_xcc_id())], 1u); }
        __syncthreads();
    }
    for (int it_ = ph_lo; it_ < ph_hi; ++it_) {
        if (ph_hi > 1000000) grid.sync();
        if (it_ > ph_lo) {
            PP pb = (PP)__builtin_amdgcn_kernarg_segment_ptr(); asm volatile("" : "+s"(pb));
            xcd_barrier((unsigned*)(pb->ws + WS_BAR), (volatile LAS unsigned*)((LAS unsigned char*)shm + LDS_BYTES));
        }
        const int ph = (REPEAT_PH >= 0 && it_ > REPEAT_PH) ? it_ - 1 : it_;
        PP p = (PP)__builtin_amdgcn_kernarg_segment_ptr();
        asm volatile("" : "+s"(p));
        int TID = threadIdx.x, BID = blockIdx.x; LAS unsigned char* lds = (LAS unsigned char*)shm;
        asm volatile("" : "+v"(TID)); asm volatile("" : "+s"(BID)); asm volatile("" : "+s"(lds));
        bf16_t* XB = (bf16_t*)(p->ws + WS_XB); bf16_t* AB = (bf16_t*)(p->ws + WS_AB);
        stat_t* STATS = (stat_t*)(p->ws + WS_STATS);
        int kind;
        switch (ph) {
            case 0: kind = 0; break;
            case 1: case 3: case 8: case 10: case 13: case 15: case 17: case 19: kind = 1; break;
            case 2: case 9: case 14: case 18: kind = 2; break;
            case 4: kind = 3; break;
            case 5: kind = 4; break;
            case 6: kind = 5; break;
            case 7: kind = 6; break;
            case 11: kind = 7; break;
            case 12: kind = 8; break;
            default: kind = 9; break;
        }
        if (kind == 0) {
            for (int i = BID * 512 + TID; i < 8 * T; i += gridDim.x * 512) STATS[i] = 0ull;
            conv_phase(TID, BID, p, (LAS unsigned*)lds);
            poolp_phase<false>(TID, BID, p->x, p->norm_mix, AB, (LAS float*)lds, nullptr);
        } else if (kind == 9) {
            poolp_phase<true>(TID, BID, XB, p->norm_mix + 3 * D, AB, (LAS float*)lds, STATS + 6 * T);
        } else if (kind == 1) {
            pg8::Gemm g; pg8::EpiRes E; int ngroups = 1;
            g.M = T; E.col_off = 0; E.colscale = nullptr; E.srcf = nullptr; E.srcb = XB; E.dstf = nullptr; E.xb = XB;
            if (ph == 1 || ph == 17) {
                const int j = (ph == 17);
                g.A = AB; g.lda = D; g.Bt = (const bf16_t*)(p->ws + WS_WPOOL) + (size_t)j * 4 * 512 * 512; g.ldb = 512; g.N = 512; g.K = 512; ngroups = 4;
                E.colscale = p->pool_scale + j * D; if (!j) E.srcf = p->x; E.stats = STATS + (j ? 7 : 0) * T;
            } else if (ph == 8) { g.A = AB; g.lda = D; g.Bt = (const bf16_t*)(p->ws + WS_WAO); g.ldb = 2048; g.N = 2048; g.K = 2048; E.stats = STATS + 2 * T; }
            else if (ph == 13) { g.A = AB; g.lda = D; g.Bt = (const bf16_t*)(p->ws + WS_WSO); g.ldb = 2048; g.N = 2048; g.K = 2048; E.stats = STATS + 5 * T; }
            else {
                const int L = (ph == 3) ? 0 : (ph == 10) ? 1 : (ph == 15) ? 2 : 3;
                g.A = (const bf16_t*)(p->ws + WS_BIG); g.lda = FF; g.Bt = (const bf16_t*)(p->ws + WS_WDN) + (size_t)L * 2048 * 8192; g.ldb = 8192; g.N = 2048; g.K = 8192;
                E.stats = (L == 0) ? STATS + 1 * T : (L == 1) ? STATS + 3 * T : (L == 2) ? STATS + 6 * T : nullptr;
                if (L == 3) { E.dstf = p->out; E.xb = nullptr; }
            }
            const bf16_t* A0 = g.A; const bf16_t* B0 = g.Bt;
            for (int gi = 0; gi < ngroups; ++gi) {
                g.A = A0 + gi * 512; g.Bt = B0 + (size_t)gi * 512 * 512; E.col_off = gi * 512;
                pg8::StaticOrder S; S.init(g.M, g.N, (int)gridDim.x, (int)((BID + gi * (gridDim.x / 4)) % gridDim.x));
                pg8::gemm_phase<pg8::EpiRes>(TID, BID, lds, g, S, E);
            }
        } else if (kind == 2) {
            const int L = (ph == 2) ? 0 : (ph == 9) ? 1 : (ph == 14) ? 2 : 3;
            pg8::Gemm g; g.A = XB; g.lda = D; g.Bt = (const bf16_t*)(p->ws + WS_WUP) + (size_t)L * 2048 * 8192; g.ldb = 2048; g.M = T; g.N = FF; g.K = 2048;
            pg8::EpiUp E; E.U = (bf16_t*)(p->ws + WS_BIG); E.stats = STATS + ((L == 0) ? 0 : (L == 1) ? 2 : (L == 2) ? 5 : 7) * T;
            pg8::StaticOrder S; S.init(g.M, g.N, (int)gridDim.x, (int)BID);
            pg8::gemm_phase<pg8::EpiUp>(TID, BID, lds, g, S, E);
        } else if (kind == 3) {
            pg8::Gemm g; g.A = XB; g.lda = D; g.Bt = (const bf16_t*)(p->ws + WS_WAIN); g.ldb = 2048; g.M = T; g.N = 4096; g.K = 2048;
            pg8::EpiRaw E; E.raw = (bf16_t*)(p->ws + WS_BIG); E.stats = STATS + 1 * T;
            { pg8::StaticOrder S; S.init(g.M, g.N, (int)gridDim.x, BID); pg8::gemm_phase<pg8::EpiRaw>(TID, BID, lds, g, S, E); }
            pg8::EpiRawT ET; ET.stats = STATS + 1 * T;
            for (int kq = 0; kq < 4; ++kq) {
                g.A = XB + kq * 512; g.Bt = (const bf16_t*)(p->ws + WS_WAIN) + (size_t)4096 * 2048 + kq * 512; g.N = 256; g.K = 512;
                ET.raw = (float*)(p->ws + WS_RAWT) + (size_t)kq * T * 256;
                pg8::StaticOrder S; S.init(g.M, g.N, (int)gridDim.x, (int)((BID + gridDim.x - 32 * kq) % gridDim.x));
                pg8::gemm_phase<pg8::EpiRawT>(TID, BID, lds, g, S, ET);
            }
        } else if (kind == 4) {
            prep_phase(TID, BID, p);
        } else if (kind == 5) {
            idx_phase(TID, BID, p, lds);
        } else if (kind == 6) {
            attn_phase(TID, BID, p, lds);
        } else if (kind == 7) {
            pg8::Gemm g; g.A = XB; g.lda = D; g.Bt = (const bf16_t*)(p->ws + WS_WSIN); g.ldb = 2048; g.M = T; g.N = 4096; g.K = 2048;
            pg8::EpiSgu E; E.uv = (bf16_t*)(p->ws + WS_BIG); E.stats = STATS + 3 * T; E.bias = p->sgu_b_in; E.stats_v = STATS + 4 * T;
            pg8::StaticOrder S; S.init(g.M, g.N, (int)gridDim.x, (int)BID);
            pg8::gemm_phase<pg8::EpiSgu>(TID, BID, lds, g, S, E);
        } else {
            mix_phase(TID, BID, p, lds);
        }
    }
}

extern "C" void kernel_launch(void* const* d_in, const int* in_sizes, int n_in, void* d_out, int out_size, void* d_ws, size_t ws_size, hipStream_t stream) {
    static int grid = 0;
    if (grid == 0) {
        if (n_in != 17 || ws_size < WS_END) { fprintf(stderr, "kernel_launch: unexpected n_in %d or ws_size %zu (< %zu)\n", n_in, ws_size, (size_t)WS_END); grid = -1; return; }
        int dev = 0, cus = 0, per_cu = 0;
        hipGetDevice(&dev); hipDeviceGetAttribute(&cus, hipDeviceAttributeMultiprocessorCount, dev);
        if (hipFuncSetAttribute((const void*)mega, hipFuncAttributeMaxDynamicSharedMemorySize, LDS_BYTES + 16) != hipSuccess) { fprintf(stderr, "kernel_launch: hipFuncSetAttribute failed\n"); grid = -1; return; }
        if (hipOccupancyMaxActiveBlocksPerMultiprocessor(&per_cu, (const void*)mega, 512, LDS_BYTES + 16) != hipSuccess || per_cu < 1) { fprintf(stderr, "kernel_launch: occupancy query gave %d\n", per_cu); per_cu = 1; }
        (void)hipGetLastError();
        grid = cus * 1;
        fprintf(stderr, "kernel_launch: cus %d per_cu %d grid %d\n", cus, per_cu, grid);
    }
    if (grid < 0) return;
    (void)hipMemsetAsync((unsigned char*)d_ws + WS_BAR, 0, 16384, stream);
    Params p{};
    const float** pp = (const float**)&p;
    for (int i = 0; i < 17; ++i) pp[i] = (const float*)d_in[i];
    p.out = (float*)d_out; p.ws = (unsigned char*)d_ws;
#if ONE_LAUNCH
    p.phase_lo = 0; p.phase_hi = NPHASE + (REPEAT_PH >= 0 ? 1 : 0);
    void* args[] = {&p};
    hipError_t e = hipLaunchCooperativeKernel((const void*)mega, dim3(grid), dim3(512), args, LDS_BYTES + 16, stream);
    if (e != hipSuccess) fprintf(stderr, "cooperative launch failed: %s (grid %d)\n", hipGetErrorString(e), grid);
#else
    for (int ph = 0; ph < NPHASE; ++ph) {
        p.phase_lo = ph; p.phase_hi = ph + 1;
        hipLaunchKernelGGL(mega, dim3(grid), dim3(512), LDS_BYTES + 16, stream, p);
    }
#endif
}
```

```cpp
#include <hip/hip_runtime.h>
#include <hip/hip_cooperative_groups.h>
#include <cstdio>
namespace cg = cooperative_groups;

#ifndef ONE_LAUNCH
#define ONE_LAUNCH 1
#endif

#ifndef REPEAT_PH
#define REPEAT_PH -1
#endif
#define LAS __attribute__((address_space(3)))
typedef unsigned short bf16_t;
typedef short bf16x8 __attribute__((ext_vector_type(8)));
typedef float f32x4 __attribute__((ext_vector_type(4)));
typedef float f32x16 __attribute__((ext_vector_type(16)));
typedef float f32x2 __attribute__((ext_vector_type(2)));
typedef unsigned u32x4 __attribute__((ext_vector_type(4)));
typedef unsigned u32x2 __attribute__((ext_vector_type(2)));

constexpr int T = 8192, D = 2048, SEQ = 4096, FF = 8192, NIN = 4176, NINP = 4352;
constexpr int LDS_BYTES = 4096 + 8 * 16384;
constexpr int NPHASE = 20;

constexpr size_t WS_WPOOL = 0;
constexpr size_t WS_WAIN = WS_WPOOL + (size_t)2 * 4 * 512 * 512 * 2;
constexpr size_t WS_WAO = WS_WAIN + (size_t)NINP * 2048 * 2;
constexpr size_t WS_WSIN = WS_WAO + (size_t)2048 * 2048 * 2;
constexpr size_t WS_WSO = WS_WSIN + (size_t)4096 * 2048 * 2;
constexpr size_t WS_WUP = WS_WSO + (size_t)2048 * 2048 * 2;
constexpr size_t WS_WDN = WS_WUP + (size_t)4 * 8192 * 2048 * 2;
constexpr size_t WS_XF = WS_WDN + (size_t)4 * 8192 * 2048 * 2;
constexpr size_t WS_XB = WS_XF + (size_t)T * D * 4;
constexpr size_t WS_AB = WS_XB + (size_t)T * D * 2;
constexpr size_t WS_BIG = WS_AB + (size_t)T * D * 2;
constexpr size_t WS_QB = WS_BIG + (size_t)T * NINP * 4;
constexpr size_t WS_KB = WS_QB + (size_t)T * 2048 * 2;
constexpr size_t WS_VB = WS_KB + (size_t)T * 512 * 2;
constexpr size_t WS_QIB = WS_VB + (size_t)T * 512 * 2;
constexpr size_t WS_KIB = WS_QIB + (size_t)T * 1024 * 2;
constexpr size_t WS_WI = WS_KIB + (size_t)T * 64 * 2;
constexpr size_t WS_STATS = WS_WI + (size_t)T * 16 * 4;
constexpr size_t WS_BAR = WS_STATS + (size_t)8 * T * 8;
constexpr size_t WS_RAWT = WS_BAR + 16384;
constexpr size_t WS_END = WS_RAWT + (size_t)4 * T * 256 * 4;

struct Params {
    const float *x, *norm_mix, *norm_ffn, *pool_w, *pool_scale, *attn_w_in, *attn_q_gain, *attn_k_gain, *attn_w_o, *sgu_w_in, *sgu_b_in, *sgu_v_gain, *sgu_w_s, *sgu_b_s,
        *sgu_w_o, *ffn_w_up, *ffn_w_down;
    float* out;
    unsigned char* ws;
    int phase_lo, phase_hi;
};

__device__ __forceinline__ unsigned cvt_pk_bf16(float lo, float hi) { unsigned r; asm volatile("v_cvt_pk_bf16_f32 %0, %1, %2" : "=v"(r) : "v"(lo), "v"(hi)); return r; }
__device__ __forceinline__ float relu1(float a) { return __builtin_amdgcn_fmed3f(a, 0.f, 3.0e38f); }
__device__ __forceinline__ float max1(float a, float b) { return __builtin_amdgcn_fmed3f(a, b, 3.0e38f); }
__device__ __forceinline__ float bf_lo(unsigned v) { return __uint_as_float(v << 16); }
__device__ __forceinline__ float bf_hi(unsigned v) { return __uint_as_float(v & 0xffff0000u); }
__device__ __forceinline__ float wave_sum(float v) {
#pragma unroll
    for (int o = 32; o > 0; o >>= 1) v += __shfl_xor(v, o);
    return v;
}
__device__ __forceinline__ float rinv_of(float ss, float invn) { return rsqrtf(ss * invn + 1e-6f); }
typedef unsigned long long stat_t;
__device__ __forceinline__ float rinv_st(stat_t s, float invn) { return rsqrtf((float)((double)s * (1.0 / 4294967296.0)) * invn + 1e-6f); }
__device__ __forceinline__ void stat_add(stat_t* p, float ss) { __hip_atomic_fetch_add(p, (stat_t)((double)ss * 4294967296.0), __ATOMIC_RELAXED, __HIP_MEMORY_SCOPE_AGENT); }

__device__ __forceinline__ f32x2 gelu_pk(f32x2 v) {
    const f32x2 av = __builtin_elementwise_abs(v), d = av * 0.2316418882f + 1.0f;
    f32x2 t; t.x = __builtin_amdgcn_rcpf(d.x); t.y = __builtin_amdgcn_rcpf(d.y);
    f32x2 q = t * 0.5307027145f + (-0.7265760135f); q = q * t + 0.7107068705f; q = q * t + (-0.142248368f); q = q * t + 0.127414796f; q = q * t;
    const f32x2 s = (v * v) * (-0.72134752044f);
    f32x2 e; e.x = __builtin_amdgcn_exp2f(s.x); e.y = __builtin_amdgcn_exp2f(s.y);
    const f32x2 m = v * (q * e), r = v - m;
    f32x2 o; o.x = v.x < 0.f ? m.x : r.x; o.y = v.y < 0.f ? m.y : r.y; return o;
}

namespace pg8 {
constexpr int BM = 256, BK = 64, HALF = 128, HTB = HALF * BK * 2, STAGE_BYTES = 8 * HTB, NXCD = 8, WGM = 8;
__host__ __device__ __forceinline__ int lds_byte(int r, int c) { const int st = (r >> 4) * 2 + (c >> 5), rr = r & 15, cc = c & 31, ob = rr * 64 + cc * 2; return st * 1024 + (ob ^ (((ob >> 9) & 1) << 5)); }
__host__ __device__ __forceinline__ void stage_rc(int b, int& R, int& C) { const int st = b / 1024, sb = b % 1024, swz = sb ^ (((sb >> 9) & 1) << 5); R = (st >> 1) * 16 + swz / 64; C = (st & 1) * 32 + (swz % 64) / 2; }
__host__ __device__ __forceinline__ int perm32(int rho) { const int n = rho >> 4, i = rho & 15; return 8 * (i >> 2) + 4 * n + (i & 3); }

struct Unit { int pm, pn; };
struct Gemm { const bf16_t* A; const bf16_t* Bt; int M, N, K, lda, ldb; };

struct StaticOrder {
    int nM, nN, nwg, G, c;
    __device__ void init(int M, int N, int G_, int c_) { nM = M / BM; nN = N / BM; nwg = nM * nN; G = G_; c = c_; }
    __device__ bool next(int i, Unit& u) const {
        const long L = (long)i * G + c; if (L >= nwg) return false;
        int wgid = (int)L; { const int q = nwg / NXCD, r = nwg % NXCD, xcd = wgid % NXCD, off = wgid / NXCD; wgid = (xcd < r ? xcd * (q + 1) : r * (q + 1) + (xcd - r) * q) + off; }
        const int nig = WGM * nN, gid = wgid / nig, fm = gid * WGM, gsz = (nM - fm) < WGM ? (nM - fm) : WGM;
        u.pm = fm + ((wgid % nig) % gsz); u.pn = (wgid % nig) / gsz; return true;
    }
};

template <class Epi>
__device__ __forceinline__ void gemm_phase(const int TID, const int BID, LAS unsigned char* lds, const Gemm g, const StaticOrder& S, const Epi& E) {
    const int tid = TID, wid = __builtin_amdgcn_readfirstlane(tid >> 6), lane = tid & 63, wr = wid >> 2, wc = wid & 3, fr = lane & 15, fq = lane >> 4;
    const int K = g.K, nt = K / BK;
    unsigned voffA[2], voffB[2];
#pragma unroll
    for (int i = 0; i < 2; ++i) { int R, C; stage_rc(tid * 16 + i * 8192, R, C); const int Rb = Epi::PERM ? ((R & ~31) + perm32(R & 31)) : R;
        voffA[i] = (unsigned)(R * g.lda + C) * 2u; voffB[i] = (unsigned)(Rb * g.ldb + C) * 2u; }
    const size_t kstep = (size_t)(BK * 2);
    const size_t hstepA = (size_t)HALF * g.lda * 2, hstepB = (size_t)HALF * g.ldb * 2;
    const size_t tstepA = 2 * hstepA, tstepB = 2 * hstepB;
    const unsigned ldsw = (unsigned)wid * 1024u;
    const int aoff = lds_byte(wr * 64 + fr, fq * 8), boff = lds_byte(wc * 32 + fr, fq * 8);
#define PG8_SA(b, h) (((b) * 2 + (h)) * HTB)
#define PG8_SB(b, h) ((4 + (b) * 2 + (h)) * HTB)
#define PG8_STAGE(bufoff, gbase, voff) do { _Pragma("unroll") for (int _i = 0; _i < 2; ++_i) \
        __builtin_amdgcn_global_load_lds((const unsigned*)((const char*)(gbase) + (voff)[_i]), (LAS unsigned*)(lds + (bufoff) + ldsw + _i * 8192), 16, 0, 0); } while (0)
#define PG8_LDA(dst, b, h) do { _Pragma("unroll") for (int m = 0; m < 4; ++m) _Pragma("unroll") for (int k = 0; k < 2; ++k) dst[m][k] = *(const LAS bf16x8*)(lds + PG8_SA(b, h) + aoff + m * 2048 + k * 1024); } while (0)
#define PG8_LDB(dst, b, h) do { _Pragma("unroll") for (int n = 0; n < 2; ++n) _Pragma("unroll") for (int k = 0; k < 2; ++k) dst[n][k] = *(const LAS bf16x8*)(lds + PG8_SB(b, h) + boff + n * 2048 + k * 1024); } while (0)
#define PG8_MMA(ai, bj, At, Bt) do { __builtin_amdgcn_s_setprio(1); _Pragma("unroll") for (int m = 0; m < 4; ++m) _Pragma("unroll") for (int n = 0; n < 2; ++n) _Pragma("unroll") for (int k = 0; k < 2; ++k) \
        acc[ai][bj][m][n] = __builtin_amdgcn_mfma_f32_16x16x32_bf16(Bt[n][k], At[m][k], acc[ai][bj][m][n], 0, 0, 0); __builtin_amdgcn_s_setprio(0); } while (0)
#define PG8_WAIT_V(n) asm volatile("s_waitcnt vmcnt(" #n ")" ::: "memory")
#define PG8_WAIT_L(n) asm volatile("s_waitcnt lgkmcnt(" #n ")" ::: "memory")
#define PG8_BAR __builtin_amdgcn_s_barrier()
#define PG8_SCHED __builtin_amdgcn_sched_barrier(0)
    Unit cur, nxt; int ui = 0;
    if (!S.next(0, cur)) return;
    f32x4 acc[2][2][4][2];
#pragma unroll
    for (int a = 0; a < 2; ++a)
#pragma unroll
        for (int b = 0; b < 2; ++b)
#pragma unroll
            for (int m = 0; m < 4; ++m)
#pragma unroll
                for (int n = 0; n < 2; ++n) acc[a][b][m][n] = (f32x4){0.f, 0.f, 0.f, 0.f};
    bf16x8 At[4][2], B0[2][2], B1[2][2];
    const char* cA = (const char*)g.A + (size_t)cur.pm * tstepA; const char* cB = (const char*)g.Bt + (size_t)cur.pn * tstepB;
    PG8_STAGE(PG8_SB(0, 0), cB, voffB); PG8_STAGE(PG8_SA(0, 0), cA, voffA); PG8_STAGE(PG8_SB(0, 1), cB + hstepB, voffB); PG8_STAGE(PG8_SA(0, 1), cA + hstepA, voffA);
    if (wr == 1) PG8_BAR;
    PG8_WAIT_V(4); PG8_BAR;
    PG8_STAGE(PG8_SB(1, 0), cB + kstep, voffB); PG8_STAGE(PG8_SA(1, 0), cA + kstep, voffA); PG8_STAGE(PG8_SB(1, 1), cB + hstepB + kstep, voffB);
    PG8_WAIT_V(6); PG8_BAR;
    for (;;) {
        const bool has_next = S.next(ui + 1, nxt);
        const char* nA = has_next ? (const char*)g.A + (size_t)nxt.pm * tstepA : cA; const char* nB = has_next ? (const char*)g.Bt + (size_t)nxt.pn * tstepB : cB;
        for (int t = 0; t < nt; t += 2) {
            const bool last = (t == nt - 2);
            const char* a1 = cA + (size_t)(t + 1) * kstep;
            const char* a2 = last ? nA : cA + (size_t)(t + 2) * kstep; const char* b2 = last ? nB : cB + (size_t)(t + 2) * kstep;
            const char* a3 = a2 + kstep; const char* b3 = b2 + kstep;
            PG8_LDB(B0, 0, 0); PG8_SCHED; PG8_LDA(At, 0, 0); PG8_STAGE(PG8_SA(1, 1), a1 + hstepA, voffA);
            PG8_WAIT_L(8); PG8_BAR; PG8_WAIT_L(0); PG8_MMA(0, 0, At, B0); PG8_BAR; PG8_SCHED;
            PG8_LDB(B1, 0, 1); PG8_STAGE(PG8_SB(0, 0), b2, voffB);
            PG8_BAR; PG8_WAIT_L(0); PG8_MMA(0, 1, At, B1); PG8_BAR;
            PG8_LDA(At, 0, 1); PG8_STAGE(PG8_SA(0, 0), a2, voffA);
            PG8_BAR; PG8_WAIT_L(0); PG8_MMA(1, 0, At, B0); PG8_BAR; PG8_SCHED;
            PG8_STAGE(PG8_SB(0, 1), b2 + hstepB, voffB);
            PG8_WAIT_V(6); PG8_BAR; PG8_MMA(1, 1, At, B1); PG8_BAR;
            PG8_LDB(B0, 1, 0); PG8_SCHED; PG8_LDA(At, 1, 0); PG8_STAGE(PG8_SA(0, 1), a2 + hstepA, voffA);
            PG8_WAIT_L(8); PG8_BAR; PG8_WAIT_L(0); PG8_MMA(0, 0, At, B0); PG8_BAR; PG8_SCHED;
            PG8_LDB(B1, 1, 1); PG8_STAGE(PG8_SB(1, 0), b3, voffB);
            PG8_BAR; PG8_WAIT_L(0); PG8_MMA(0, 1, At, B1); PG8_BAR;
            PG8_LDA(At, 1, 1); PG8_STAGE(PG8_SA(1, 0), a3, voffA);
            PG8_BAR; PG8_WAIT_L(0); PG8_MMA(1, 0, At, B0); PG8_BAR; PG8_SCHED;
            PG8_STAGE(PG8_SB(1, 1), b3 + hstepB, voffB);
            PG8_WAIT_V(6); PG8_BAR; PG8_MMA(1, 1, At, B1); PG8_BAR;
        }
        E(acc, cur, wr, wc, fr, fq);
        if (!has_next) break;
#pragma unroll
        for (int a = 0; a < 2; ++a)
#pragma unroll
            for (int b = 0; b < 2; ++b)
#pragma unroll
                for (int m = 0; m < 4; ++m)
#pragma unroll
                    for (int n = 0; n < 2; ++n) acc[a][b][m][n] = (f32x4){0.f, 0.f, 0.f, 0.f};
        cur = nxt; cA = nA; cB = nB; ++ui;
    }
    PG8_WAIT_V(0);
    if (wr == 0) PG8_BAR;
    PG8_BAR;
#undef PG8_SA
#undef PG8_SB
#undef PG8_STAGE
#undef PG8_LDA
#undef PG8_LDB
#undef PG8_MMA
#undef PG8_WAIT_V
#undef PG8_WAIT_L
#undef PG8_BAR
#undef PG8_SCHED
}

struct EpiRes {
    static constexpr bool PERM = true;
    const float* srcf; const bf16_t* srcb; float* dstf; bf16_t* xb; const float* colscale; stat_t* stats; int col_off;
    __device__ __forceinline__ void operator()(const f32x4 (&acc)[2][2][4][2], const Unit& u, int wr, int wc, int fr, int fq) const {
        const int row0 = u.pm * BM + wr * 64 + fr, col0 = col_off + u.pn * BM + wc * 32 + 8 * fq;
        f32x4 cs[2][2];
#pragma unroll
        for (int bj = 0; bj < 2; ++bj)
#pragma unroll
            for (int n = 0; n < 2; ++n) cs[bj][n] = colscale ? *(const f32x4*)(colscale + col0 + bj * HALF + 4 * n) : (f32x4){1.f, 1.f, 1.f, 1.f};
#pragma unroll
        for (int ai = 0; ai < 2; ++ai)
#pragma unroll
            for (int m = 0; m < 4; ++m) {
                const int row = row0 + ai * HALF + m * 16; const size_t ro = (size_t)row * D + col0; float ss = 0.f;
#pragma unroll
                for (int bj = 0; bj < 2; ++bj) {
                    const size_t o = ro + bj * HALF;
                    f32x4 s0, s1;
                    if (srcf) { s0 = *(const f32x4*)(srcf + o); s1 = *(const f32x4*)(srcf + o + 4); }
                    else { const u32x4 w = *(const u32x4*)(srcb + o); s0 = (f32x4){bf_lo(w.x), bf_hi(w.x), bf_lo(w.y), bf_hi(w.y)}; s1 = (f32x4){bf_lo(w.z), bf_hi(w.z), bf_lo(w.w), bf_hi(w.w)}; }
                    const f32x4 v0 = acc[ai][bj][m][0] * cs[bj][0] + s0, v1 = acc[ai][bj][m][1] * cs[bj][1] + s1;
                    ss += v0[0] * v0[0] + v0[1] * v0[1] + v0[2] * v0[2] + v0[3] * v0[3] + v1[0] * v1[0] + v1[1] * v1[1] + v1[2] * v1[2] + v1[3] * v1[3];
                    if (dstf) { *(f32x4*)(dstf + o) = v0; *(f32x4*)(dstf + o + 4) = v1; }
                    if (xb) { u32x4 w; w.x = cvt_pk_bf16(v0[0], v0[1]); w.y = cvt_pk_bf16(v0[2], v0[3]); w.z = cvt_pk_bf16(v1[0], v1[1]); w.w = cvt_pk_bf16(v1[2], v1[3]); *(u32x4*)(xb + o) = w; }
                }
                if (stats) { ss += __shfl_xor(ss, 16); ss += __shfl_xor(ss, 32); if (fq == 0) stat_add(stats + row, ss); }
            }
    }
};
struct EpiUp {
    static constexpr bool PERM = true;
    bf16_t* U; const stat_t* stats;
    __device__ __forceinline__ void operator()(const f32x4 (&acc)[2][2][4][2], const Unit& u, int wr, int wc, int fr, int fq) const {
        const int row0 = u.pm * BM + wr * 64 + fr, col0 = u.pn * BM + wc * 32 + 8 * fq;
#pragma unroll
        for (int ai = 0; ai < 2; ++ai)
#pragma unroll
            for (int m = 0; m < 4; ++m) {
                const int row = row0 + ai * HALF + m * 16; const float r = rinv_st(stats[row], 1.0f / 2048.0f);
                bf16_t* rowp = U + (size_t)row * FF + col0;
#pragma unroll
                for (int bj = 0; bj < 2; ++bj) {
                    f32x4 v0 = acc[ai][bj][m][0] * r, v1 = acc[ai][bj][m][1] * r;
#pragma unroll
                    for (int j = 0; j < 4; ++j) { const float a = fmaxf(v0[j], 0.f), b = fmaxf(v1[j], 0.f); v0[j] = a * a; v1[j] = b * b; }
                    u32x4 w; w.x = cvt_pk_bf16(v0[0], v0[1]); w.y = cvt_pk_bf16(v0[2], v0[3]); w.z = cvt_pk_bf16(v1[0], v1[1]); w.w = cvt_pk_bf16(v1[2], v1[3]);
                    *(u32x4*)(rowp + bj * HALF) = w;
                }
            }
    }
};
struct EpiRaw {
    static constexpr bool PERM = true;
    bf16_t* raw; const stat_t* stats;
    __device__ __forceinline__ void operator()(const f32x4 (&acc)[2][2][4][2], const Unit& u, int wr, int wc, int fr, int fq) const {
        const int row0 = u.pm * BM + wr * 64 + fr, col0 = u.pn * BM + wc * 32 + 8 * fq;
#pragma unroll
        for (int ai = 0; ai < 2; ++ai)
#pragma unroll
            for (int m = 0; m < 4; ++m) {
                const int row = row0 + ai * HALF + m * 16; const float r = rinv_st(stats[row], 1.0f / 2048.0f);
                bf16_t* rowp = raw + (size_t)row * NINP + col0;
#pragma unroll
                for (int bj = 0; bj < 2; ++bj) {
                    const f32x4 v0 = acc[ai][bj][m][0] * r, v1 = acc[ai][bj][m][1] * r;
                    u32x4 w; w.x = cvt_pk_bf16(v0[0], v0[1]); w.y = cvt_pk_bf16(v0[2], v0[3]); w.z = cvt_pk_bf16(v1[0], v1[1]); w.w = cvt_pk_bf16(v1[2], v1[3]);
                    *(u32x4*)(rowp + bj * HALF) = w;
                }
            }
    }
};
struct EpiRawT {
    static constexpr bool PERM = false;
    float* raw; const stat_t* stats;
    __device__ __forceinline__ void operator()(const f32x4 (&acc)[2][2][4][2], const Unit& u, int wr, int wc, int fr, int fq) const {
        const int row0 = u.pm * BM + wr * 64 + fr, col0 = u.pn * BM + wc * 32 + 4 * fq;
#pragma unroll
        for (int ai = 0; ai < 2; ++ai)
#pragma unroll
            for (int m = 0; m < 4; ++m) {
                const int row = row0 + ai * HALF + m * 16; const float r = rinv_st(stats[row], 1.0f / 2048.0f);
                float* rowp = raw + (size_t)row * 256 + col0;
#pragma unroll
                for (int bj = 0; bj < 2; ++bj)
#pragma unroll
                    for (int n = 0; n < 2; ++n) *(f32x4*)(rowp + bj * HALF + n * 16) = acc[ai][bj][m][n] * r;
            }
    }
};
struct EpiSgu {
    static constexpr bool PERM = true;
    bf16_t* uv; const stat_t* stats; const float* bias; stat_t* stats_v;
    __device__ __forceinline__ void operator()(const f32x4 (&acc)[2][2][4][2], const Unit& u, int wr, int wc, int fr, int fq) const {
        const int row0 = u.pm * BM + wr * 64 + fr, col0 = u.pn * BM + wc * 32 + 8 * fq;
        f32x4 bv[2][2];
#pragma unroll
        for (int bj = 0; bj < 2; ++bj)
#pragma unroll
            for (int n = 0; n < 2; ++n) bv[bj][n] = *(const f32x4*)(bias + col0 + bj * HALF + 4 * n);
        const bool isv = u.pn >= 8;
#pragma unroll
        for (int ai = 0; ai < 2; ++ai)
#pragma unroll
            for (int m = 0; m < 4; ++m) {
                const int row = row0 + ai * HALF + m * 16; const float r = rinv_st(stats[row], 1.0f / 2048.0f);
                bf16_t* rowp = uv + (size_t)row * 4096 + col0; float ss = 0.f;
#pragma unroll
                for (int bj = 0; bj < 2; ++bj) {
                    const f32x4 v0 = acc[ai][bj][m][0] * r + bv[bj][0], v1 = acc[ai][bj][m][1] * r + bv[bj][1];
                    const f32x2 a = gelu_pk((f32x2){v0[0], v0[1]}), b = gelu_pk((f32x2){v0[2], v0[3]}), c = gelu_pk((f32x2){v1[0], v1[1]}), d = gelu_pk((f32x2){v1[2], v1[3]});
                    ss += a.x * a.x + a.y * a.y + b.x * b.x + b.y * b.y + c.x * c.x + c.y * c.y + d.x * d.x + d.y * d.y;
                    u32x4 w; w.x = cvt_pk_bf16(a.x, a.y); w.y = cvt_pk_bf16(b.x, b.y); w.z = cvt_pk_bf16(c.x, c.y); w.w = cvt_pk_bf16(d.x, d.y);
                    *(u32x4*)(rowp + bj * HALF) = w;
                }
                ss += __shfl_xor(ss, 16); ss += __shfl_xor(ss, 32);
                if (isv && fq == 0) stat_add(stats_v + row, ss);
            }
    }
};
}

#define CAS __attribute__((address_space(4)))
typedef const CAS Params* PP;
struct ConvDesc { const float* src; bf16_t* dst; int K, N, Npad; const float* ks; int ntiles; };
__device__ __forceinline__ ConvDesc conv_desc(PP p, int m) {
    ConvDesc d;
    if (m < 8) { d.src = p->pool_w + (size_t)m * 512 * 512; d.dst = (bf16_t*)(p->ws + WS_WPOOL) + (size_t)m * 512 * 512; d.K = 512; d.N = 512; d.Npad = 512; d.ks = nullptr; }
    else if (m == 8) { d.src = p->attn_w_in; d.dst = (bf16_t*)(p->ws + WS_WAIN); d.K = 2048; d.N = NIN; d.Npad = NINP; d.ks = p->norm_mix + 1 * D; }
    else if (m == 9) { d.src = p->attn_w_o; d.dst = (bf16_t*)(p->ws + WS_WAO); d.K = 2048; d.N = 2048; d.Npad = 2048; d.ks = nullptr; }
    else if (m == 10) { d.src = p->sgu_w_in; d.dst = (bf16_t*)(p->ws + WS_WSIN); d.K = 2048; d.N = 4096; d.Npad = 4096; d.ks = p->norm_mix + 2 * D; }
    else if (m == 11) { d.src = p->sgu_w_o; d.dst = (bf16_t*)(p->ws + WS_WSO); d.K = 2048; d.N = 2048; d.Npad = 2048; d.ks = nullptr; }
    else if (m < 16) { const int i = m - 12; d.src = p->ffn_w_up + (size_t)i * 2048 * 8192; d.dst = (bf16_t*)(p->ws + WS_WUP) + (size_t)i * 2048 * 8192; d.K = 2048; d.N = 8192; d.Npad = 8192; d.ks = p->norm_ffn + i * D; }
    else { const int i = m - 16; d.src = p->ffn_w_down + (size_t)i * 2048 * 8192; d.dst = (bf16_t*)(p->ws + WS_WDN) + (size_t)i * 2048 * 8192; d.K = 8192; d.N = 2048; d.Npad = 2048; d.ks = nullptr; }
    d.ntiles = (d.K / 64) * (d.Npad / 128);
    return d;
}

__device__ __forceinline__ void conv_load(const int TID, const ConvDesc& d, int tile, f32x4 (&a)[2][2]) {
    const int t = TID, nkb = d.K / 64, nb = tile / nkb, kb = tile % nkb;
#pragma unroll
    for (int i = 0; i < 2; ++i) {
        const int u = t + 512 * i, nq = (u & 15) + 16 * ((u >> 6) & 1), kp = ((u >> 4) & 3) + 4 * (u >> 7);
        const int k = kb * 64 + 2 * kp, n = nb * 128 + 4 * nq;
        if (n < d.N) { a[i][0] = *(const f32x4*)(d.src + (size_t)k * d.N + n); a[i][1] = *(const f32x4*)(d.src + (size_t)(k + 1) * d.N + n); }
        else { a[i][0] = (f32x4){0.f, 0.f, 0.f, 0.f}; a[i][1] = (f32x4){0.f, 0.f, 0.f, 0.f}; }
        if (d.ks) { a[i][0] *= d.ks[k]; a[i][1] *= d.ks[k + 1]; }
    }
}

__device__ __forceinline__ void conv_phase(const int TID, const int BID, PP p, LAS unsigned* ldsw) {
    const int t = TID, G = gridDim.x;
    int m = 0; ConvDesc d = conv_desc(p, 0); int base = 0;
    int total = 0;
    for (int i = 0; i < 20; ++i) total += conv_desc(p, i).ntiles;
    int gid = BID;
    f32x4 a[2][2];
    bool have = gid < total;
    if (have) { while (gid >= base + d.ntiles) { base += d.ntiles; ++m; d = conv_desc(p, m); } conv_load(TID, d, gid - base, a); }
    while (have) {
        const ConvDesc cd = d; const int ctile = gid - base;
        __syncthreads();
#pragma unroll
        for (int i = 0; i < 2; ++i) {
            const int u = t + 512 * i, nq = (u & 15) + 16 * ((u >> 6) & 1), kp = ((u >> 4) & 3) + 4 * (u >> 7);
#pragma unroll
            for (int e = 0; e < 4; ++e) ldsw[(4 * nq + e) * 33 + kp] = cvt_pk_bf16(a[i][0][e], a[i][1][e]);
        }
        gid += G; have = gid < total;
        if (have) { while (gid >= base + d.ntiles) { base += d.ntiles; ++m; d = conv_desc(p, m); } conv_load(TID, d, gid - base, a); }
        __syncthreads();
        {
            const int nkb = cd.K / 64, nb = ctile / nkb, kb = ctile % nkb, n = t >> 2, kc = t & 3;
            unsigned w[8];
#pragma unroll
            for (int j = 0; j < 8; ++j) w[j] = ldsw[n * 33 + kc * 8 + j];
            bf16_t* o = cd.dst + (size_t)(nb * 128 + n) * cd.K + kb * 64 + kc * 16;
            *(u32x4*)o = (u32x4){w[0], w[1], w[2], w[3]}; *(u32x4*)(o + 8) = (u32x4){w[4], w[5], w[6], w[7]};
        }
    }
    __syncthreads();
}

template <bool BF> __device__ __forceinline__ f32x4 ld4(const void* base, size_t idx) {
    if (BF) { const u32x2 w = *(const u32x2*)((const bf16_t*)base + idx); return (f32x4){bf_lo(w.x), bf_hi(w.x), bf_lo(w.y), bf_hi(w.y)}; }
    else return *(const f32x4*)((const float*)base + idx);
}
template <bool BF, int W> __device__ __forceinline__ void poolp_chunk(const void* xsrc, size_t xb0, int s_base, int s0, int c, f32x4 g4, const LAS float* rinv, bf16_t* Pout) {
    f32x4 h[W + 8];
#pragma unroll
    for (int r = 0; r < W + 8; ++r) {
        const int s = s_base - W + r;
        if (s >= 0) h[r] = ld4<BF>(xsrc, xb0 + (size_t)s * D + c) * (g4 * rinv[s - s0 + 16]);
        else h[r] = (f32x4){0.f, 0.f, 0.f, 0.f};
    }
    f32x4 S = (f32x4){0.f, 0.f, 0.f, 0.f};
#pragma unroll
    for (int i = 0; i < W; ++i) S += h[i];
#pragma unroll
    for (int tt = 0; tt < 8; ++tt) {
        const int s = s_base + tt;
        S += h[W + tt] - h[tt];
        const float inv = 1.0f / (float)min(s + 1, W);
        const f32x4 pv = S * inv - h[W + tt];
        u32x2 o; o.x = cvt_pk_bf16(pv[0], pv[1]); o.y = cvt_pk_bf16(pv[2], pv[3]);
        *(u32x2*)(Pout + (size_t)tt * D) = o;
    }
}
template <bool BF> __device__ __forceinline__ void poolp_phase(const int TID, const int BID, const void* xsrc, const float* gain, bf16_t* P, LAS float* ldsf, const stat_t* stats) {
    const int t = TID, wv = t >> 6, lane = t & 63;
    for (int item = BID; item < 256; item += gridDim.x) {
        const int tok0 = item * 32, b = tok0 >> 12, s0 = tok0 & 4095;
        const size_t xb0 = (size_t)b * SEQ * D;
        if (stats) {
            if (t < 48) { const int s = s0 - 16 + t; ldsf[t] = (s >= 0) ? rinv_st(stats[b * SEQ + s], 1.0f / 2048.0f) : 0.f; }
        } else {
#pragma unroll
            for (int half = 0; half < 2; ++half) {
                f32x4 v[3][8];
#pragma unroll
                for (int k = 0; k < 3; ++k) { const int s = s0 - 16 + wv + 8 * (3 * half + k);
#pragma unroll
                    for (int i = 0; i < 8; ++i) v[k][i] = (s >= 0) ? ld4<BF>(xsrc, xb0 + (size_t)s * D + 4 * (lane + 64 * i)) : (f32x4){0.f, 0.f, 0.f, 0.f}; }
#pragma unroll
                for (int k = 0; k < 3; ++k) { float ss = 0.f;
#pragma unroll
                    for (int i = 0; i < 8; ++i) ss += v[k][i][0] * v[k][i][0] + v[k][i][1] * v[k][i][1] + v[k][i][2] * v[k][i][2] + v[k][i][3] * v[k][i][3];
                    ss = wave_sum(ss);
                    if (lane == 0) ldsf[wv + 8 * (3 * half + k)] = rinv_of(ss, 1.0f / 2048.0f); }
            }
        }
        __syncthreads();
        const int c = 4 * t; const f32x4 g4 = *(const f32x4*)(gain + c);
        for (int ch = 0; ch < 4; ++ch) {
            bf16_t* Pout = P + (size_t)(tok0 + 8 * ch) * D + c;
            switch (t >> 7) {
                case 0: poolp_chunk<BF, 2>(xsrc, xb0, s0 + 8 * ch, s0, c, g4, ldsf, Pout); break;
                case 1: poolp_chunk<BF, 4>(xsrc, xb0, s0 + 8 * ch, s0, c, g4, ldsf, Pout); break;
                case 2: poolp_chunk<BF, 8>(xsrc, xb0, s0 + 8 * ch, s0, c, g4, ldsf, Pout); break;
                default: poolp_chunk<BF, 16>(xsrc, xb0, s0 + 8 * ch, s0, c, g4, ldsf, Pout); break;
            }
        }
        __syncthreads();
    }
}

__device__ __forceinline__ void rope_cs(int pos, float inv, float& c, float& s) {
    double rev = (double)pos * (double)inv * 0.15915494309189535; rev -= __builtin_rint(rev);
    const float f = (float)rev; s = __builtin_amdgcn_sinf(f); c = __builtin_amdgcn_cosf(f);
}
__device__ __forceinline__ void prep_phase(const int TID, const int BID, PP p) {
    const int lane = TID & 63, wg = BID * 8 + (TID >> 6), nw = gridDim.x * 8;
    const bf16_t* raw = (const bf16_t*)(p->ws + WS_BIG); const float* rawt = (const float*)(p->ws + WS_RAWT);
    bf16_t* Qb = (bf16_t*)(p->ws + WS_QB); bf16_t* Kb = (bf16_t*)(p->ws + WS_KB); bf16_t* Vb = (bf16_t*)(p->ws + WS_VB);
    bf16_t* QIb = (bf16_t*)(p->ws + WS_QIB); bf16_t* KIb = (bf16_t*)(p->ws + WS_KIB); float* WI = (float*)(p->ws + WS_WI);
    const float L2T = 18.931568569324174f;
    for (int tok = wg; tok < T; tok += nw) {
        const bf16_t* r = raw + (size_t)tok * NINP; const int pos = tok & 4095;
        float cq[4], sq[4], ci[4], si[4];
        { const int j = lane & 3, ji = lane & 1;
#pragma unroll
          for (int e = 0; e < 4; ++e) {
              rope_cs(pos, exp2f(-(float)(4 * j + e) * (L2T / 16.0f)), cq[e], sq[e]);
              rope_cs(pos, exp2f(-(float)(4 * ji + e) * (L2T / 8.0f)), ci[e], si[e]); } }
#pragma unroll
        for (int it = 0; it < 10; ++it) {
            const int head = 2 * it + (lane >> 5), j = lane & 31;
            const bool isq = head < 16;
            const int col = isq ? head * 128 : 2048 + (head - 16) * 128;
            const u32x2 rw = *(const u32x2*)(r + col + 4 * j);
            f32x4 v = (f32x4){bf_lo(rw.x), bf_hi(rw.x), bf_lo(rw.y), bf_hi(rw.y)};
            float ss = v[0] * v[0] + v[1] * v[1] + v[2] * v[2] + v[3] * v[3];
#pragma unroll
            for (int o = 16; o > 0; o >>= 1) ss += __shfl_xor(ss, o);
            const float rn = rinv_of(ss, 1.0f / 128.0f);
            const f32x4 g4 = *(const f32x4*)((isq ? p->attn_q_gain : p->attn_k_gain) + 4 * j);
            v = v * rn * g4;
            f32x4 pt;
#pragma unroll
            for (int e = 0; e < 4; ++e) pt[e] = __shfl_xor(v[e], 4);
            if (j < 8) {
#pragma unroll
                for (int e = 0; e < 4; ++e) v[e] = (j < 4) ? v[e] * cq[e] - pt[e] * sq[e] : v[e] * cq[e] + pt[e] * sq[e];
            }
            u32x2 o; o.x = cvt_pk_bf16(v[0], v[1]); o.y = cvt_pk_bf16(v[2], v[3]);
            { int w8 = __builtin_amdgcn_cvt_pk_fp8_f32(v[0], v[1], 0, false); w8 = __builtin_amdgcn_cvt_pk_fp8_f32(v[2], v[3], w8, true);
              if (isq) *(int*)((unsigned char*)Qb + (size_t)tok * 2048 + head * 128 + 4 * j) = w8;
              else *(int*)((unsigned char*)Kb + (size_t)tok * 512 + (head - 16) * 128 + 4 * j) = w8; }
        }
        { const u32x4 vw = *(const u32x4*)(r + 2560 + 8 * lane);
          int lo = __builtin_amdgcn_cvt_pk_fp8_f32(bf_lo(vw.x), bf_hi(vw.x), 0, false); lo = __builtin_amdgcn_cvt_pk_fp8_f32(bf_lo(vw.y), bf_hi(vw.y), lo, true);
          int hi = __builtin_amdgcn_cvt_pk_fp8_f32(bf_lo(vw.z), bf_hi(vw.z), 0, false); hi = __builtin_amdgcn_cvt_pk_fp8_f32(bf_lo(vw.w), bf_hi(vw.w), hi, true);
          *(u32x2*)((unsigned char*)Vb + (size_t)tok * 512 + 8 * lane) = (u32x2){(unsigned)lo, (unsigned)hi}; }
#pragma unroll
        for (int it = 0; it < 5; ++it) {
            const int j = lane & 15;
            const int head = 4 * it + (lane >> 4);
            const int col = (it < 4) ? 3072 + head * 64 : 4096;
            f32x4 v;
            if (it < 4) { const u32x2 rw = *(const u32x2*)(r + col + 4 * j); v = (f32x4){bf_lo(rw.x), bf_hi(rw.x), bf_lo(rw.y), bf_hi(rw.y)}; }
            else { const float* rt = rawt + (size_t)tok * 256 + 4 * j; v = *(const f32x4*)rt + *(const f32x4*)(rt + (size_t)T * 256) + *(const f32x4*)(rt + (size_t)2 * T * 256) + *(const f32x4*)(rt + (size_t)3 * T * 256); }
            f32x4 pt;
#pragma unroll
            for (int e = 0; e < 4; ++e) pt[e] = __shfl_xor(v[e], 2);
            if (j < 4) {
#pragma unroll
                for (int e = 0; e < 4; ++e) v[e] = (j < 2) ? v[e] * ci[e] - pt[e] * si[e] : v[e] * ci[e] + pt[e] * si[e];
            }
            u32x2 o; o.x = cvt_pk_bf16(v[0], v[1]); o.y = cvt_pk_bf16(v[2], v[3]);
            if (it < 4) *(u32x2*)(QIb + (size_t)tok * 1024 + head * 64 + 4 * j) = o;
            else if (lane < 16) *(u32x2*)(KIb + (size_t)tok * 64 + 4 * j) = o;
        }
        if (lane < 16) { const float* rt = rawt + (size_t)tok * 256 + 64 + lane; WI[(size_t)tok * 16 + lane] = (rt[0] + rt[(size_t)T * 256] + rt[(size_t)2 * T * 256] + rt[(size_t)3 * T * 256]) * 0.03125f; }
    }
}

__device__ __forceinline__ void idx_phase(const int TID, const int BID, PP p, LAS unsigned char* lds) {
    const int t = TID, lane = t & 63, wv = t >> 6;
    const bf16_t* QIb = (const bf16_t*)(p->ws + WS_QIB); const bf16_t* KIb = (const bf16_t*)(p->ws + WS_KIB); const float* WI = (const float*)(p->ws + WS_WI);
    _Float16* Sc = (_Float16*)(p->ws + WS_BIG);
    const int rr = lane & 31, g2 = lane >> 5;
    for (int item = BID; item < 1088; item += gridDim.x) {
        const int b = item / 544; int rem = item % 544;
        int a = 0; while (rem >= 4 * (a + 1)) { rem -= 4 * (a + 1); ++a; }
        const int c = 4 * a + rem / (a + 1), kb = rem % (a + 1);
        const int key0 = kb * 256, Nk = (c + 1) * 64, nkeys = min(256, Nk - key0);
        __syncthreads();
        { const int key = t >> 1, half = t & 1;
          if (key < nkeys) { const bf16_t* src = KIb + (size_t)(b * SEQ + key0 + key) * 64 + half * 32;
#pragma unroll
              for (int j = 0; j < 4; ++j) *(LAS u32x4*)(lds + key * 144 + half * 64 + j * 16) = *(const u32x4*)(src + j * 8); } }
        __syncthreads();
        for (int pr = 0; pr < 4; ++pr) {
            const int tokq = b * SEQ + c * 64 + wv * 8 + 2 * pr;
            bf16x8 A[4]; float wq[16];
            { const bf16_t* src = QIb + (size_t)(tokq + (rr >> 4)) * 1024 + (rr & 15) * 64 + g2 * 32;
#pragma unroll
              for (int ks = 0; ks < 4; ++ks) A[ks] = *(const bf16x8*)(src + ks * 8); }
#pragma unroll
            for (int i = 0; i < 16; ++i) wq[i] = WI[(size_t)(tokq + (i >> 3)) * 16 + 8 * ((i >> 2) & 1) + 4 * g2 + (i & 3)];
            for (int kt = 0; kt < nkeys / 32; kt += 2) {
                f32x16 acc0, acc1;
#pragma unroll
                for (int i = 0; i < 16; ++i) { acc0[i] = 0.f; acc1[i] = 0.f; }
                bf16x8 Bf0[4], Bf1[4];
#pragma unroll
                for (int ks = 0; ks < 4; ++ks) { Bf0[ks] = *(const LAS bf16x8*)(lds + (kt * 32 + rr) * 144 + g2 * 64 + ks * 16); Bf1[ks] = *(const LAS bf16x8*)(lds + ((kt + 1) * 32 + rr) * 144 + g2 * 64 + ks * 16); }
#pragma unroll
                for (int ks = 0; ks < 4; ++ks) { acc0 = __builtin_amdgcn_mfma_f32_32x32x16_bf16(A[ks], Bf0[ks], acc0, 0, 0, 0); acc1 = __builtin_amdgcn_mfma_f32_32x32x16_bf16(A[ks], Bf1[ks], acc1, 0, 0, 0); }
                float s0 = 0.f, s1 = 0.f, t0 = 0.f, t1 = 0.f;
#pragma unroll
                for (int i = 0; i < 8; ++i) { s0 += relu1(acc0[i]) * wq[i]; s1 += relu1(acc0[8 + i]) * wq[8 + i]; t0 += relu1(acc1[i]) * wq[i]; t1 += relu1(acc1[8 + i]) * wq[8 + i]; }
                s0 += __shfl_xor(s0, 32); s1 += __shfl_xor(s1, 32); t0 += __shfl_xor(t0, 32); t1 += __shfl_xor(t1, 32);
                _Float16* so = Sc + (size_t)(tokq + g2) * SEQ + key0 + kt * 32 + rr;
                so[0] = (_Float16)(g2 ? s1 : s0); so[32] = (_Float16)(g2 ? t1 : t0);
            }
        }
    }
}

__device__ __forceinline__ unsigned fkey(float f) { const unsigned u = __float_as_uint(f); return (u & 0x80000000u) ? ~u : (u | 0x80000000u); }

__device__ __forceinline__ void attn_phase(const int TID, const int BID, PP p, LAS unsigned char* lds) {
    const int lane = TID & 63, wv = __builtin_amdgcn_readfirstlane(TID >> 6), wg = BID * 8 + wv, nw = gridDim.x * 8;
    const _Float16* Sc = (const _Float16*)(p->ws + WS_BIG);
    const bf16_t* Qb = (const bf16_t*)(p->ws + WS_QB); const bf16_t* Kb = (const bf16_t*)(p->ws + WS_KB); const bf16_t* Vb = (const bf16_t*)(p->ws + WS_VB);
    bf16_t* O = (bf16_t*)(p->ws + WS_AB);
    LAS unsigned short* widx = (LAS unsigned short*)(lds + wv * 512);
    LAS unsigned char* vt = lds + 4096 + wv * 16384;
    const int fr = lane & 15, fq = lane >> 4;
    for (int tok = wg; tok < T; tok += nw) {
        const int b = tok >> 12, s = tok & 4095, Nk = ((s >> 6) + 1) * 64, nsel = min(Nk, 256);
        if (Nk <= 256) {
#pragma unroll
            for (int i = 0; i < 4; ++i) { const int slot = lane + 64 * i; if (slot < Nk) widx[slot] = slot; }
        } else {
            unsigned key[64];
            int ln = lane; asm volatile("" : "+v"(ln));
            const _Float16* srow = Sc + (size_t)tok * SEQ;
#pragma unroll
            for (int i = 0; i < 16; ++i) {
                const int k0 = i * 256 + 4 * ln;
                if (k0 < Nk) { typedef _Float16 h16x4 __attribute__((ext_vector_type(4))); const h16x4 hv = *(const h16x4*)(srow + k0); const f32x4 v = (f32x4){(float)hv[0], (float)hv[1], (float)hv[2], (float)hv[3]};
#pragma unroll
                    for (int e = 0; e < 4; ++e) key[4 * i + e] = fkey(v[e]); }
                else {
#pragma unroll
                    for (int e = 0; e < 4; ++e) key[4 * i + e] = 0u; }
            }
            const int nib = (Nk + 255) >> 8;
            unsigned Tt = 0u;
            for (int bit = 31; bit >= 0; --bit) {
                const unsigned cand = Tt | (1u << bit);
                int c = 0;
#pragma unroll
                for (int ib = 0; ib < 16; ++ib)
                    if (ib < nib) {
#pragma unroll
                        for (int e = 0; e < 4; ++e) c += (key[4 * ib + e] >= cand) ? 1 : 0;
                    }
                int cnt = 0;
#pragma unroll
                for (int bp = 0; bp < 7; ++bp) cnt += __popcll(__ballot((c >> bp) & 1)) << bp;
                if (cnt >= 256) { Tt = cand; if (cnt == 256) break; }
            }
            int cnt_gt = 0;
#pragma unroll
            for (int ib = 0; ib < 16; ++ib)
                if (ib < nib) {
#pragma unroll
                    for (int e = 0; e < 4; ++e) cnt_gt += __popcll(__ballot(key[4 * ib + e] > Tt));
                }
            const int need = 256 - cnt_gt;
            int base = 0, tbase = 0;
#pragma unroll
            for (int j = 0; j < 64; ++j) if ((j >> 2) < nib) {
                const int kidx = (j >> 2) * 256 + 4 * ln + (j & 3);
                const bool gt = key[j] > Tt; const unsigned long long m1 = __ballot(gt);
                const int pre = __builtin_amdgcn_mbcnt_hi((unsigned)(m1 >> 32), __builtin_amdgcn_mbcnt_lo((unsigned)m1, 0));
                if (gt) widx[base + pre] = kidx;
                base += __popcll(m1);
                const bool eq = key[j] == Tt; const unsigned long long m2 = __ballot(eq);
                if (m2) {
                    const int pre2 = __builtin_amdgcn_mbcnt_hi((unsigned)(m2 >> 32), __builtin_amdgcn_mbcnt_lo((unsigned)m2, 0));
                    if (eq && tbase + pre2 < need) widx[cnt_gt + tbase + pre2] = kidx;
                    tbase += __popcll(m2);
                }
            }
        }
        __builtin_amdgcn_wave_barrier();
        asm volatile("s_waitcnt lgkmcnt(0)" ::: "memory");
        const bf16_t* Kbase = Kb + (size_t)(b * SEQ) * 512; const bf16_t* Vbase = Vb + (size_t)(b * SEQ) * 512;
        const int nblk = nsel >> 6;
        for (int g = 0; g < 4; ++g) {
            f32x4 sc[16];
            {
                long q8[4];
                { const unsigned char* qp = (const unsigned char*)Qb + (size_t)tok * 2048 + (g * 4 + (lane & 3)) * 128 + fq * 8;
#pragma unroll
                  for (int ks = 0; ks < 4; ++ks) q8[ks] = *(const long*)(qp + ks * 32); }
                u32x4 R[3][4];
                const unsigned char* kg = (const unsigned char*)Kb + (size_t)(b * SEQ) * 512 + g * 128 + (lane & 7) * 16;
                LAS unsigned char* ktw = vt + (lane >> 3) * 144 + (lane & 7) * 16;
                const LAS unsigned char* ktr = vt + fr * 144 + fq * 8;
                const int nst = nsel >> 5;
#define QK_LOAD(set, st) do { _Pragma("unroll") for (int i = 0; i < 4; ++i) { const int row = widx[(st) * 32 + i * 8 + (lane >> 3)] & 4095; R[set][i] = *(const u32x4*)(kg + (size_t)row * 512); } __builtin_amdgcn_sched_barrier(0); } while (0)
#define QK_STEP(set, st, more) do { \
                _Pragma("unroll") for (int i = 0; i < 4; ++i) *(LAS u32x4*)(ktw + i * 8 * 144) = R[set][i]; \
                __builtin_amdgcn_sched_barrier(0); \
                if (more) QK_LOAD(set, (st) + 3); \
                if ((st) < nst) { long af[2][4]; \
                    _Pragma("unroll") for (int tt = 0; tt < 2; ++tt) _Pragma("unroll") for (int ks = 0; ks < 4; ++ks) af[tt][ks] = *(const LAS long*)(ktr + tt * 16 * 144 + ks * 32); \
                    f32x4 a0 = (f32x4){0.f, 0.f, 0.f, 0.f}, a1 = a0, a2 = a0, a3 = a0;        \
                    a0 = __builtin_amdgcn_mfma_f32_16x16x32_fp8_fp8(af[0][0], q8[0], a0, 0, 0, 0); a1 = __builtin_amdgcn_mfma_f32_16x16x32_fp8_fp8(af[1][0], q8[0], a1, 0, 0, 0); \
                    a2 = __builtin_amdgcn_mfma_f32_16x16x32_fp8_fp8(af[0][2], q8[2], a2, 0, 0, 0); a3 = __builtin_amdgcn_mfma_f32_16x16x32_fp8_fp8(af[1][2], q8[2], a3, 0, 0, 0); \
                    a0 = __builtin_amdgcn_mfma_f32_16x16x32_fp8_fp8(af[0][1], q8[1], a0, 0, 0, 0); a1 = __builtin_amdgcn_mfma_f32_16x16x32_fp8_fp8(af[1][1], q8[1], a1, 0, 0, 0); \
                    a2 = __builtin_amdgcn_mfma_f32_16x16x32_fp8_fp8(af[0][3], q8[3], a2, 0, 0, 0); a3 = __builtin_amdgcn_mfma_f32_16x16x32_fp8_fp8(af[1][3], q8[3], a3, 0, 0, 0); \
                    sc[(st) * 2] = a0 + a2; sc[(st) * 2 + 1] = a1 + a3; } \
                else { sc[(st) * 2] = (f32x4){-INFINITY, -INFINITY, -INFINITY, -INFINITY}; sc[(st) * 2 + 1] = (f32x4){-INFINITY, -INFINITY, -INFINITY, -INFINITY}; } \
                __builtin_amdgcn_sched_barrier(0); } while (0)
                QK_LOAD(0, 0); QK_LOAD(1, 1); QK_LOAD(2, 2);
                QK_STEP(0, 0, true); QK_STEP(1, 1, true); QK_STEP(2, 2, true); QK_STEP(0, 3, true); QK_STEP(1, 4, true);
                QK_STEP(2, 5, false); QK_STEP(0, 6, false); QK_STEP(1, 7, false);
#undef QK_LOAD
#undef QK_STEP
            }
            float mx = -INFINITY;
#pragma unroll
            for (int kt = 0; kt < 16; ++kt)
#pragma unroll
                for (int i = 0; i < 4; ++i) mx = max1(mx, sc[kt][i]);
            mx = fmaxf(mx, __shfl_xor(mx, 16)); mx = fmaxf(mx, __shfl_xor(mx, 32));
            const float sl2 = 0.08838834764831845f * 1.4426950408889634f;
            float sum = 0.f; const float nmxs = -mx * sl2;
#pragma unroll
            for (int kt = 0; kt < 16; ++kt)
#pragma unroll
                for (int i = 0; i < 4; ++i) { const float e = __builtin_amdgcn_exp2f(fmaf(sc[kt][i], sl2, nmxs)); sc[kt][i] = e; sum += e; }
            sum += __shfl_xor(sum, 16); sum += __shfl_xor(sum, 32);
            const float inv = 1.0f / sum;
            float invh[4];
#pragma unroll
            for (int i = 0; i < 4; ++i) invh[i] = __shfl(inv, i);
            long Af[8];
#pragma unroll
            for (int s2 = 0; s2 < 8; ++s2) {
                int lo = __builtin_amdgcn_cvt_pk_fp8_f32(sc[2 * s2][0], sc[2 * s2][1], 0, false); lo = __builtin_amdgcn_cvt_pk_fp8_f32(sc[2 * s2][2], sc[2 * s2][3], lo, true);
                int hi = __builtin_amdgcn_cvt_pk_fp8_f32(sc[2 * s2 + 1][0], sc[2 * s2 + 1][1], 0, false); hi = __builtin_amdgcn_cvt_pk_fp8_f32(sc[2 * s2 + 1][2], sc[2 * s2 + 1][3], hi, true);
                Af[s2] = (long)(((unsigned long long)(unsigned)hi << 32) | (unsigned)lo);
            }
            f32x4 acc[8];
#pragma unroll
            for (int nt = 0; nt < 8; ++nt) acc[nt] = (f32x4){0.f, 0.f, 0.f, 0.f};
            u32x4 R[3][4];
            const unsigned char* vg = (const unsigned char*)Vb + (size_t)(b * SEQ) * 512 + g * 128 + (lane & 7) * 16;
            LAS unsigned char* vtw = vt + (lane >> 3) * 144 + (lane & 7) * 16;
            const int rho0 = lane >> 3;
            const int slot0 = 16 * (rho0 >> 2) + (rho0 & 3);
            const unsigned trb = (unsigned)(size_t)(vt + (fq * 8 + (fr >> 1)) * 144 + (fr & 1) * 8);
#define PV_LOAD(set, st) do { _Pragma("unroll") for (int i = 0; i < 4; ++i) { const int row = widx[(st) * 32 + slot0 + 4 * i] & 4095; R[set][i] = *(const u32x4*)(vg + (size_t)row * 512); } __builtin_amdgcn_sched_barrier(0); } while (0)
#define PV_TR(dst, off) asm volatile("ds_read_b64_tr_b8 %0, %1 offset:" #off : "=v"(dst) : "v"(trb) : "memory")
#define PV_STEP(set, st, more) do { \
                _Pragma("unroll") for (int i = 0; i < 4; ++i) *(LAS u32x4*)(vtw + i * 8 * 144) = R[set][i]; \
                __builtin_amdgcn_sched_barrier(0); \
                if (more) PV_LOAD(set, (st) + 3); \
                u32x2 b0[8]; \
                PV_TR(b0[0], 0); PV_TR(b0[1], 16); PV_TR(b0[2], 32); PV_TR(b0[3], 48); PV_TR(b0[4], 64); PV_TR(b0[5], 80); PV_TR(b0[6], 96); PV_TR(b0[7], 112); \
                asm volatile("s_waitcnt lgkmcnt(0)" : "+v"(b0[0]), "+v"(b0[1]), "+v"(b0[2]), "+v"(b0[3]), "+v"(b0[4]), "+v"(b0[5]), "+v"(b0[6]), "+v"(b0[7]) :: "memory"); \
                _Pragma("unroll") for (int nt = 0; nt < 8; ++nt) \
                    acc[nt] = __builtin_amdgcn_mfma_f32_16x16x32_fp8_fp8(Af[st], __builtin_bit_cast(long, b0[nt]), acc[nt], 0, 0, 0); \
                __builtin_amdgcn_sched_barrier(0); } while (0)
            PV_LOAD(0, 0); PV_LOAD(1, 1); PV_LOAD(2, 2);
            PV_STEP(0, 0, true); PV_STEP(1, 1, true); PV_STEP(2, 2, true); PV_STEP(0, 3, true); PV_STEP(1, 4, true);
            PV_STEP(2, 5, false); PV_STEP(0, 6, false); PV_STEP(1, 7, false);
#undef PV_LOAD
#undef PV_TR
#undef PV_STEP
#pragma unroll
            for (int nt = 0; nt < 8; ++nt)
                if ((nt >> 1) == fq) {
#pragma unroll
                    for (int i = 0; i < 4; ++i) O[(size_t)tok * 2048 + (g * 4 + i) * 128 + nt * 16 + fr] = (bf16_t)(cvt_pk_bf16(acc[nt][i] * invh[i], 0.f) & 0xffffu);
                }
        }
        __builtin_amdgcn_wave_barrier();
    }
}

__device__ __forceinline__ void mix_phase(const int TID, const int BID, PP p, LAS unsigned char* lds) {
    const int t = TID, lane = t & 63, wv = t >> 6;
    const bf16_t* uv = (const bf16_t*)(p->ws + WS_BIG); const stat_t* stats_v = (const stat_t*)(p->ws + WS_STATS) + 4 * T;
    bf16_t* AB = (bf16_t*)(p->ws + WS_AB);
    LAS float* rinv = (LAS float*)lds; LAS unsigned char* Wsl = lds + 1024; LAS unsigned char* Vt = lds + 1024 + 128 * 272;
    const int rr = lane & 31, g2 = lane >> 5, it_ = wv & 3, ch = wv >> 2;
    for (int item = BID; item < 512; item += gridDim.x) {
        const int n = item >> 3, g = item & 7;
        __syncthreads();
        if (t < 128) rinv[t] = rinv_st(stats_v[n * 128 + t], 1.0f / 2048.0f);
        __syncthreads();
        { const int i = t >> 2, jseg = (t & 3) * 32; const float* wsrc = p->sgu_w_s + ((size_t)g * 128 + i) * 128 + jseg;
#pragma unroll
          for (int q = 0; q < 4; ++q) {
              f32x4 a = *(const f32x4*)(wsrc + q * 8), bq = *(const f32x4*)(wsrc + q * 8 + 4);
              const int j0 = jseg + q * 8; const bool ok = (j0 >> 6) <= (i >> 6);
              u32x4 w;
              if (ok) { w.x = cvt_pk_bf16(a[0] * rinv[j0], a[1] * rinv[j0 + 1]); w.y = cvt_pk_bf16(a[2] * rinv[j0 + 2], a[3] * rinv[j0 + 3]);
                        w.z = cvt_pk_bf16(bq[0] * rinv[j0 + 4], bq[1] * rinv[j0 + 5]); w.w = cvt_pk_bf16(bq[2] * rinv[j0 + 6], bq[3] * rinv[j0 + 7]); }
              else w = (u32x4){0u, 0u, 0u, 0u};
              *(LAS u32x4*)(Wsl + i * 272 + j0 * 2) = w;
          } }
        { const int j = t & 127, cgp = t >> 7; const bf16_t* vsrc = uv + (size_t)(n * 128 + j) * 4096 + 2048 + g * 256;
#pragma unroll
          for (int q = 0; q < 8; ++q) {
              const int c = (q * 4 + cgp) * 8; const u32x4 v = *(const u32x4*)(vsrc + c);
#pragma unroll
              for (int e = 0; e < 4; ++e) { *(LAS bf16_t*)(Vt + (c + 2 * e) * 272 + j * 2) = (bf16_t)(v[e] & 0xffffu); *(LAS bf16_t*)(Vt + (c + 2 * e + 1) * 272 + j * 2) = (bf16_t)(v[e] >> 16); }
          } }
        __syncthreads();
        f32x16 acc[4];
#pragma unroll
        for (int ct = 0; ct < 4; ++ct)
#pragma unroll
            for (int i = 0; i < 16; ++i) acc[ct][i] = 0.f;
#pragma unroll
        for (int ks = 0; ks < 8; ++ks) {
            const bf16x8 Af = *(const LAS bf16x8*)(Wsl + (it_ * 32 + rr) * 272 + (ks * 16 + g2 * 8) * 2);
#pragma unroll
            for (int ct = 0; ct < 4; ++ct) { const bf16x8 Bf = *(const LAS bf16x8*)(Vt + (ch * 128 + ct * 32 + rr) * 272 + (ks * 16 + g2 * 8) * 2); acc[ct] = __builtin_amdgcn_mfma_f32_32x32x16_bf16(Af, Bf, acc[ct], 0, 0, 0); }
        }
#pragma unroll
        for (int ct = 0; ct < 4; ++ct) {
            const int cg_ = g * 256 + ch * 128 + ct * 32 + rr; const float gain = p->sgu_v_gain[cg_];
#pragma unroll
            for (int r = 0; r < 16; ++r) {
                const int i = it_ * 32 + (r & 3) + 8 * (r >> 2) + 4 * g2; const size_t tok = (size_t)n * 128 + i;
                const float mixed = gain * acc[ct][r] + p->sgu_b_s[g * 128 + i];
                const float uval = __uint_as_float((unsigned)uv[tok * 4096 + cg_] << 16);
                AB[tok * 2048 + cg_] = (bf16_t)(cvt_pk_bf16(uval * mixed, 0.f) & 0xffffu);
            }
        }
    }
}

#define XB_TMO      128
#define XB_XCNT(j)  (256  + 64 * (j))
#define XB_XSUB(j)  (1280 + 64 * (j))
#define XB_XGEN(j)  (2304 + 64 * (j))
#define XB_TOP      3328
#define XB_TOPGEN   3392
#define XCD_BAR_WORDS 3456
#define XB_SPIN_CAP (1u << 22)
__device__ __forceinline__ unsigned xb_ld(unsigned* p)              { return __hip_atomic_load(p, __ATOMIC_RELAXED, __HIP_MEMORY_SCOPE_AGENT); }
__device__ __forceinline__ unsigned xb_add(unsigned* p, unsigned v) { return __hip_atomic_fetch_add(p, v, __ATOMIC_RELAXED, __HIP_MEMORY_SCOPE_AGENT); }
__device__ __forceinline__ unsigned xb_xcc_id() { return (unsigned)__builtin_amdgcn_s_getreg((3 << 11) | 20) & 0xFu; }
#define XB_SPIN(cond, bar) do { unsigned _sp = 0; while (cond) { __builtin_amdgcn_s_sleep(1); \
    if ((++_sp & 255u) == 0u) { if (xb_ld(&(bar)[XB_TMO])) break; if (_sp > XB_SPIN_CAP) { atomicAdd(&(bar)[XB_TMO], 1u); break; } } } } while (0)
__device__ __forceinline__ void xcd_barrier_complete(unsigned* bar, unsigned x, unsigned& nloc, unsigned& nx) {
    const unsigned G = gridDim.x * gridDim.y * gridDim.z;
    unsigned sum, cnt, mine, sp = 0u;
    for (;;) {
        sum = 0u; cnt = 0u; mine = 0u;
#pragma unroll
        for (unsigned j = 0; j < 16; ++j) { const unsigned c = xb_ld(&bar[XB_XCNT(j)]); sum += c; cnt += (c > 0u) ? 1u : 0u; mine = (j == x) ? c : mine; }
        if (sum == G) break;
        __builtin_amdgcn_s_sleep(1);
        if ((++sp & 255u) == 0u) { if (xb_ld(&bar[XB_TMO])) break; if (sp > XB_SPIN_CAP) { atomicAdd(&bar[XB_TMO], 1u); break; } }
    }
    nloc = mine > 0u ? mine : 1u; nx = cnt > 0u ? cnt : 1u;
}
__device__ __forceinline__ void xcd_barrier(unsigned* bar, volatile LAS unsigned* st) {
    asm volatile("s_waitcnt vmcnt(0)" ::: "memory");
    __syncthreads();
    if (threadIdx.x == 0) {
        const unsigned x = xb_xcc_id();
        __builtin_amdgcn_s_waitcnt(0);
        unsigned nloc = st[0], nx = st[1];
        if (nloc == 0u) { xcd_barrier_complete(bar, x, nloc, nx); st[0] = nloc; st[1] = nx; }
        const unsigned old = xb_add(&bar[XB_XSUB(x)], 1u);
        const unsigned gen = old / nloc;
        if (old + 1u == (gen + 1u) * nloc) {
            __builtin_amdgcn_fence(__ATOMIC_RELEASE, "agent");
            asm volatile("s_waitcnt vmcnt(0)" ::: "memory");
            const unsigned og = xb_add(&bar[XB_TOP], 1u);
            const unsigned tg = og / nx;
            if (og + 1u == (tg + 1u) * nx) xb_add(&bar[XB_TOPGEN], 1u);
            else XB_SPIN(xb_ld(&bar[XB_TOPGEN]) == tg, bar);
            __builtin_amdgcn_fence(__ATOMIC_ACQUIRE, "agent");
            xb_add(&bar[XB_XGEN(x)], 1u);
            asm volatile("s_waitcnt vmcnt(0)" ::: "memory");
        } else {
            XB_SPIN(xb_ld(&bar[XB_XGEN(x)]) == gen, bar);
            __builtin_amdgcn_fence(__ATOMIC_ACQUIRE, "agent");
            asm volatile("s_waitcnt vmcnt(0)" ::: "memory");
        }
    }
    __syncthreads();
}

__global__ __launch_bounds__(512, 2) void mega(Params p_) {
    extern __shared__ __attribute__((aligned(16))) unsigned char shm[];
    cg::grid_group grid = cg::this_grid();
    const int ph_lo = p_.phase_lo, ph_hi = p_.phase_hi;
    {
        volatile LAS unsigned* st0 = (volatile LAS unsigned*)((LAS unsigned char*)shm + LDS_BYTES);
        if (threadIdx.x == 0) { st0[0] = 0u; st0[1] = 0u; (void)xb_add(&((unsigned*)(p_.ws + WS_BAR))[XB_XCNT(xb_xcc_id())], 1u); }
        __syncthreads();
    }
    for (int it_ = ph_lo; it_ < ph_hi; ++it_) {
        if (ph_hi > 1000000) grid.sync();
        if (it_ > ph_lo) {
            PP pb = (PP)__builtin_amdgcn_kernarg_segment_ptr(); asm volatile("" : "+s"(pb));
            xcd_barrier((unsigned*)(pb->ws + WS_BAR), (volatile LAS unsigned*)((LAS unsigned char*)shm + LDS_BYTES));
        }
        const int ph = (REPEAT_PH >= 0 && it_ > REPEAT_PH) ? it_ - 1 : it_;
        PP p = (PP)__builtin_amdgcn_kernarg_segment_ptr();
        asm volatile("" : "+s"(p));
        int TID = threadIdx.x, BID = blockIdx.x; LAS unsigned char* lds = (LAS unsigned char*)shm;
        asm volatile("" : "+v"(TID)); asm volatile("" : "+s"(BID)); asm volatile("" : "+s"(lds));
        bf16_t* XB = (bf16_t*)(p->ws + WS_XB); bf16_t* AB = (bf16_t*)(p->ws + WS_AB);
        stat_t* STATS = (stat_t*)(p->ws + WS_STATS);
        int kind;
        switch (ph) {
            case 0: kind = 0; break;
            case 1: case 3: case 8: case 10: case 13: case 15: case 17: case 19: kind = 1; break;
            case 2: case 9: case 14: case 18: kind = 2; break;
            case 4: kind = 3; break;
            case 5: kind = 4; break;
            case 6: kind = 5; break;
            case 7: kind = 6; break;
            case 11: kind = 7; break;
            case 12: kind = 8; break;
            default: kind = 9; break;
        }
        if (kind == 0) {
            for (int i = BID * 512 + TID; i < 8 * T; i += gridDim.x * 512) STATS[i] = 0ull;
            conv_phase(TID, BID, p, (LAS unsigned*)lds);
            poolp_phase<false>(TID, BID, p->x, p->norm_mix, AB, (LAS float*)lds, nullptr);
        } else if (kind == 9) {
            poolp_phase<true>(TID, BID, XB, p->norm_mix + 3 * D, AB, (LAS float*)lds, STATS + 6 * T);
        } else if (kind == 1) {
            pg8::Gemm g; pg8::EpiRes E; int ngroups = 1;
            g.M = T; E.col_off = 0; E.colscale = nullptr; E.srcf = nullptr; E.srcb = XB; E.dstf = nullptr; E.xb = XB;
            if (ph == 1 || ph == 17) {
                const int j = (ph == 17);
                g.A = AB; g.lda = D; g.Bt = (const bf16_t*)(p->ws + WS_WPOOL) + (size_t)j * 4 * 512 * 512; g.ldb = 512; g.N = 512; g.K = 512; ngroups = 4;
                E.colscale = p->pool_scale + j * D; if (!j) E.srcf = p->x; E.stats = STATS + (j ? 7 : 0) * T;
            } else if (ph == 8) { g.A = AB; g.lda = D; g.Bt = (const bf16_t*)(p->ws + WS_WAO); g.ldb = 2048; g.N = 2048; g.K = 2048; E.stats = STATS + 2 * T; }
            else if (ph == 13) { g.A = AB; g.lda = D; g.Bt = (const bf16_t*)(p->ws + WS_WSO); g.ldb = 2048; g.N = 2048; g.K = 2048; E.stats = STATS + 5 * T; }
            else {
                const int L = (ph == 3) ? 0 : (ph == 10) ? 1 : (ph == 15) ? 2 : 3;
                g.A = (const bf16_t*)(p->ws + WS_BIG); g.lda = FF; g.Bt = (const bf16_t*)(p->ws + WS_WDN) + (size_t)L * 2048 * 8192; g.ldb = 8192; g.N = 2048; g.K = 8192;
                E.stats = (L == 0) ? STATS + 1 * T : (L == 1) ? STATS + 3 * T : (L == 2) ? STATS + 6 * T : nullptr;
                if (L == 3) { E.dstf = p->out; E.xb = nullptr; }
            }
            const bf16_t* A0 = g.A; const bf16_t* B0 = g.Bt;
            for (int gi = 0; gi < ngroups; ++gi) {
                g.A = A0 + gi * 512; g.Bt = B0 + (size_t)gi * 512 * 512; E.col_off = gi * 512;
                pg8::StaticOrder S; S.init(g.M, g.N, (int)gridDim.x, (int)((BID + gi * (gridDim.x / 4)) % gridDim.x));
                pg8::gemm_phase<pg8::EpiRes>(TID, BID, lds, g, S, E);
            }
        } else if (kind == 2) {
            const int L = (ph == 2) ? 0 : (ph == 9) ? 1 : (ph == 14) ? 2 : 3;
            pg8::Gemm g; g.A = XB; g.lda = D; g.Bt = (const bf16_t*)(p->ws + WS_WUP) + (size_t)L * 2048 * 8192; g.ldb = 2048; g.M = T; g.N = FF; g.K = 2048;
            pg8::EpiUp E; E.U = (bf16_t*)(p->ws + WS_BIG); E.stats = STATS + ((L == 0) ? 0 : (L == 1) ? 2 : (L == 2) ? 5 : 7) * T;
            pg8::StaticOrder S; S.init(g.M, g.N, (int)gridDim.x, (int)BID);
            pg8::gemm_phase<pg8::EpiUp>(TID, BID, lds, g, S, E);
        } else if (kind == 3) {
            pg8::Gemm g; g.A = XB; g.lda = D; g.Bt = (const bf16_t*)(p->ws + WS_WAIN); g.ldb = 2048; g.M = T; g.N = 4096; g.K = 2048;
            pg8::EpiRaw E; E.raw = (bf16_t*)(p->ws + WS_BIG); E.stats = STATS + 1 * T;
            { pg8::StaticOrder S; S.init(g.M, g.N, (int)gridDim.x, BID); pg8::gemm_phase<pg8::EpiRaw>(TID, BID, lds, g, S, E); }
            pg8::EpiRawT ET; ET.stats = STATS + 1 * T;
            for (int kq = 0; kq < 4; ++kq) {
                g.A = XB + kq * 512; g.Bt = (const bf16_t*)(p->ws + WS_WAIN) + (size_t)4096 * 2048 + kq * 512; g.N = 256; g.K = 512;
                ET.raw = (float*)(p->ws + WS_RAWT) + (size_t)kq * T * 256;
                pg8::StaticOrder S; S.init(g.M, g.N, (int)gridDim.x, (int)((BID + gridDim.x - 32 * kq) % gridDim.x));
                pg8::gemm_phase<pg8::EpiRawT>(TID, BID, lds, g, S, ET);
            }
        } else if (kind == 4) {
            prep_phase(TID, BID, p);
        } else if (kind == 5) {
            idx_phase(TID, BID, p, lds);
        } else if (kind == 6) {
            attn_phase(TID, BID, p, lds);
        } else if (kind == 7) {
            pg8::Gemm g; g.A = XB; g.lda = D; g.Bt = (const bf16_t*)(p->ws + WS_WSIN); g.ldb = 2048; g.M = T; g.N = 4096; g.K = 2048;
            pg8::EpiSgu E; E.uv = (bf16_t*)(p->ws + WS_BIG); E.stats = STATS + 3 * T; E.bias = p->sgu_b_in; E.stats_v = STATS + 4 * T;
            pg8::StaticOrder S; S.init(g.M, g.N, (int)gridDim.x, (int)BID);
            pg8::gemm_phase<pg8::EpiSgu>(TID, BID, lds, g, S, E);
        } else {
            mix_phase(TID, BID, p, lds);
        }
    }
}

extern "C" void kernel_launch(void* const* d_in, const int* in_sizes, int n_in, void* d_out, int out_size, void* d_ws, size_t ws_size, hipStream_t stream) {
    static int grid = 0;
    if (grid == 0) {
        if (n_in != 17 || ws_size < WS_END) { fprintf(stderr, "kernel_launch: unexpected n_in %d or ws_size %zu (< %zu)\n", n_in, ws_size, (size_t)WS_END); grid = -1; return; }
        int dev = 0, cus = 0, per_cu = 0;
        hipGetDevice(&dev); hipDeviceGetAttribute(&cus, hipDeviceAttributeMultiprocessorCount, dev);
        if (hipFuncSetAttribute((const void*)mega, hipFuncAttributeMaxDynamicSharedMemorySize, LDS_BYTES + 16) != hipSuccess) { fprintf(stderr, "kernel_launch: hipFuncSetAttribute failed\n"); grid = -1; return; }
        if (hipOccupancyMaxActiveBlocksPerMultiprocessor(&per_cu, (const void*)mega, 512, LDS_BYTES + 16) != hipSuccess || per_cu < 1) { fprintf(stderr, "kernel_launch: occupancy query gave %d\n", per_cu); per_cu = 1; }
        (void)hipGetLastError();
        grid = cus * 1;
        fprintf(stderr, "kernel_launch: cus %d per_cu %d grid %d\n", cus, per_cu, grid);
    }
    if (grid < 0) return;
    (void)hipMemsetAsync((unsigned char*)d_ws + WS_BAR, 0, 16384, stream);
    Params p{};
    const float** pp = (const float**)&p;
    for (int i = 0; i < 17; ++i) pp[i] = (const float*)d_in[i];
    p.out = (float*)d_out; p.ws = (unsigned char*)d_ws;
#if ONE_LAUNCH
    p.phase_lo = 0; p.phase_hi = NPHASE + (REPEAT_PH >= 0 ? 1 : 0);
    void* args[] = {&p};
    hipError_t e = hipLaunchCooperativeKernel((const void*)mega, dim3(grid), dim3(512), args, LDS_BYTES + 16, stream);
    if (e != hipSuccess) fprintf(stderr, "cooperative launch failed: %s (grid %d)\n", hipGetErrorString(e), grid);
#else
    for (int ph = 0; ph < NPHASE; ++ph) {
        p.phase_lo = ph; p.phase_hi = ph + 1;
        hipLaunchKernelGGL(mega, dim3(grid), dim3(512), LDS_BYTES + 16, stream, p);
    }
#endif
}
```

```cpp
#include <hip/hip_runtime.h>
#include <hip/hip_cooperative_groups.h>
#include <cstdio>
namespace cg = cooperative_groups;

#ifndef ONE_LAUNCH
#define ONE_LAUNCH 1
#endif

#ifndef REPEAT_PH
#define REPEAT_PH -1
#endif
#define LAS __attribute__((address_space(3)))
typedef unsigned short bf16_t;
typedef short bf16x8 __attribute__((ext_vector_type(8)));
typedef float f32x4 __attribute__((ext_vector_type(4)));
typedef float f32x16 __attribute__((ext_vector_type(16)));
typedef float f32x2 __attribute__((ext_vector_type(2)));
typedef unsigned u32x4 __attribute__((ext_vector_type(4)));
typedef unsigned u32x2 __attribute__((ext_vector_type(2)));

constexpr int T = 8192, D = 2048, SEQ = 4096, FF = 8192, NIN = 4176, NINP = 4352;
constexpr int LDS_BYTES = 4096 + 8 * 16384;
constexpr int NPHASE = 20;

constexpr size_t WS_WPOOL = 0;
constexpr size_t WS_WAIN = WS_WPOOL + (size_t)2 * 4 * 512 * 512 * 2;
constexpr size_t WS_WAO = WS_WAIN + (size_t)NINP * 2048 * 2;
constexpr size_t WS_WSIN = WS_WAO + (size_t)2048 * 2048 * 2;
constexpr size_t WS_WSO = WS_WSIN + (size_t)4096 * 2048 * 2;
constexpr size_t WS_WUP = WS_WSO + (size_t)2048 * 2048 * 2;
constexpr size_t WS_WDN = WS_WUP + (size_t)4 * 8192 * 2048 * 2;
constexpr size_t WS_XF = WS_WDN + (size_t)4 * 8192 * 2048 * 2;
constexpr size_t WS_XB = WS_XF + (size_t)T * D * 4;
constexpr size_t WS_AB = WS_XB + (size_t)T * D * 2;
constexpr size_t WS_BIG = WS_AB + (size_t)T * D * 2;
constexpr size_t WS_QB = WS_BIG + (size_t)T * NINP * 4;
constexpr size_t WS_KB = WS_QB + (size_t)T * 2048 * 2;
constexpr size_t WS_VB = WS_KB + (size_t)T * 512 * 2;
constexpr size_t WS_QIB = WS_VB + (size_t)T * 512 * 2;
constexpr size_t WS_KIB = WS_QIB + (size_t)T * 1024 * 2;
constexpr size_t WS_WI = WS_KIB + (size_t)T * 64 * 2;
constexpr size_t WS_STATS = WS_WI + (size_t)T * 16 * 4;
constexpr size_t WS_BAR = WS_STATS + (size_t)8 * T * 8;
constexpr size_t WS_RAWT = WS_BAR + 16384;
constexpr size_t WS_END = WS_RAWT + (size_t)4 * T * 256 * 4;

struct Params {
    const float *x, *norm_mix, *norm_ffn, *pool_w, *pool_scale, *attn_w_in, *attn_q_gain, *attn_k_gain, *attn_w_o, *sgu_w_in, *sgu_b_in, *sgu_v_gain, *sgu_w_s, *sgu_b_s,
        *sgu_w_o, *ffn_w_up, *ffn_w_down;
    float* out;
    unsigned char* ws;
    int phase_lo, phase_hi;
};

__device__ __forceinline__ unsigned cvt_pk_bf16(float lo, float hi) { unsigned r; asm volatile("v_cvt_pk_bf16_f32 %0, %1, %2" : "=v"(r) : "v"(lo), "v"(hi)); return r; }
__device__ __forceinline__ float relu1(float a) { return __builtin_amdgcn_fmed3f(a, 0.f, 3.0e38f); }
__device__ __forceinline__ float max1(float a, float b) { return __builtin_amdgcn_fmed3f(a, b, 3.0e38f); }
__device__ __forceinline__ float bf_lo(unsigned v) { return __uint_as_float(v << 16); }
__device__ __forceinline__ float bf_hi(unsigned v) { return __uint_as_float(v & 0xffff0000u); }
__device__ __forceinline__ float wave_sum(float v) {
#pragma unroll
    for (int o = 32; o > 0; o >>= 1) v += __shfl_xor(v, o);
    return v;
}
__device__ __forceinline__ float rinv_of(float ss, float invn) { return rsqrtf(ss * invn + 1e-6f); }
typedef unsigned long long stat_t;
__device__ __forceinline__ float rinv_st(stat_t s, float invn) { return rsqrtf((float)((double)s * (1.0 / 4294967296.0)) * invn + 1e-6f); }
__device__ __forceinline__ void stat_add(stat_t* p, float ss) { __hip_atomic_fetch_add(p, (stat_t)((double)ss * 4294967296.0), __ATOMIC_RELAXED, __HIP_MEMORY_SCOPE_AGENT); }

__device__ __forceinline__ f32x2 gelu_pk(f32x2 v) {
    const f32x2 av = __builtin_elementwise_abs(v), d = av * 0.2316418882f + 1.0f;
    f32x2 t; t.x = __builtin_amdgcn_rcpf(d.x); t.y = __builtin_amdgcn_rcpf(d.y);
    f32x2 q = t * 0.5307027145f + (-0.7265760135f); q = q * t + 0.7107068705f; q = q * t + (-0.142248368f); q = q * t + 0.127414796f; q = q * t;
    const f32x2 s = (v * v) * (-0.72134752044f);
    f32x2 e; e.x = __builtin_amdgcn_exp2f(s.x); e.y = __builtin_amdgcn_exp2f(s.y);
    const f32x2 m = v * (q * e), r = v - m;
    f32x2 o; o.x = v.x < 0.f ? m.x : r.x; o.y = v.y < 0.f ? m.y : r.y; return o;
}

namespace pg8 {
constexpr int BM = 256, BK = 64, HALF = 128, HTB = HALF * BK * 2, STAGE_BYTES = 8 * HTB, NXCD = 8, WGM = 8;
__host__ __device__ __forceinline__ int lds_byte(int r, int c) { const int st = (r >> 4) * 2 + (c >> 5), rr = r & 15, cc = c & 31, ob = rr * 64 + cc * 2; return st * 1024 + (ob ^ (((ob >> 9) & 1) << 5)); }
__host__ __device__ __forceinline__ void stage_rc(int b, int& R, int& C) { const int st = b / 1024, sb = b % 1024, swz = sb ^ (((sb >> 9) & 1) << 5); R = (st >> 1) * 16 + swz / 64; C = (st & 1) * 32 + (swz % 64) / 2; }
__host__ __device__ __forceinline__ int perm32(int rho) { const int n = rho >> 4, i = rho & 15; return 8 * (i >> 2) + 4 * n + (i & 3); }

struct Unit { int pm, pn; };
struct Gemm { const bf16_t* A; const bf16_t* Bt; int M, N, K, lda, ldb; };

struct StaticOrder {
    int nM, nN, nwg, G, c;
    __device__ void init(int M, int N, int G_, int c_) { nM = M / BM; nN = N / BM; nwg = nM * nN; G = G_; c = c_; }
    __device__ bool next(int i, Unit& u) const {
        const long L = (long)i * G + c; if (L >= nwg) return false;
        int wgid = (int)L; { const int q = nwg / NXCD, r = nwg % NXCD, xcd = wgid % NXCD, off = wgid / NXCD; wgid = (xcd < r ? xcd * (q + 1) : r * (q + 1) + (xcd - r) * q) + off; }
        const int nig = WGM * nN, gid = wgid / nig, fm = gid * WGM, gsz = (nM - fm) < WGM ? (nM - fm) : WGM;
        u.pm = fm + ((wgid % nig) % gsz); u.pn = (wgid % nig) / gsz; return true;
    }
};

template <class Epi>
__device__ __forceinline__ void gemm_phase(const int TID, const int BID, LAS unsigned char* lds, const Gemm g, const StaticOrder& S, const Epi& E) {
    const int tid = TID, wid = __builtin_amdgcn_readfirstlane(tid >> 6), lane = tid & 63, wr = wid >> 2, wc = wid & 3, fr = lane & 15, fq = lane >> 4;
    const int K = g.K, nt = K / BK;
    unsigned voffA[2], voffB[2];
#pragma unroll
    for (int i = 0; i < 2; ++i) { int R, C; stage_rc(tid * 16 + i * 8192, R, C); const int Rb = Epi::PERM ? ((R & ~31) + perm32(R & 31)) : R;
        voffA[i] = (unsigned)(R * g.lda + C) * 2u; voffB[i] = (unsigned)(Rb * g.ldb + C) * 2u; }
    const size_t kstep = (size_t)(BK * 2);
    const size_t hstepA = (size_t)HALF * g.lda * 2, hstepB = (size_t)HALF * g.ldb * 2;
    const size_t tstepA = 2 * hstepA, tstepB = 2 * hstepB;
    const unsigned ldsw = (unsigned)wid * 1024u;
    const int aoff = lds_byte(wr * 64 + fr, fq * 8), boff = lds_byte(wc * 32 + fr, fq * 8);
#define PG8_SA(b, h) (((b) * 2 + (h)) * HTB)
#define PG8_SB(b, h) ((4 + (b) * 2 + (h)) * HTB)
#define PG8_STAGE(bufoff, gbase, voff) do { _Pragma("unroll") for (int _i = 0; _i < 2; ++_i) \
        __builtin_amdgcn_global_load_lds((const unsigned*)((const char*)(gbase) + (voff)[_i]), (LAS unsigned*)(lds + (bufoff) + ldsw + _i * 8192), 16, 0, 0); } while (0)
#define PG8_LDA(dst, b, h) do { _Pragma("unroll") for (int m = 0; m < 4; ++m) _Pragma("unroll") for (int k = 0; k < 2; ++k) dst[m][k] = *(const LAS bf16x8*)(lds + PG8_SA(b, h) + aoff + m * 2048 + k * 1024); } while (0)
#define PG8_LDB(dst, b, h) do { _Pragma("unroll") for (int n = 0; n < 2; ++n) _Pragma("unroll") for (int k = 0; k < 2; ++k) dst[n][k] = *(const LAS bf16x8*)(lds + PG8_SB(b, h) + boff + n * 2048 + k * 1024); } while (0)
#define PG8_MMA(ai, bj, At, Bt) do { __builtin_amdgcn_s_setprio(1); _Pragma("unroll") for (int m = 0; m < 4; ++m) _Pragma("unroll") for (int n = 0; n < 2; ++n) _Pragma("unroll") for (int k = 0; k < 2; ++k) \
        acc[ai][bj][m][n] = __builtin_amdgcn_mfma_f32_16x16x32_bf16(Bt[n][k], At[m][k], acc[ai][bj][m][n], 0, 0, 0); __builtin_amdgcn_s_setprio(0); } while (0)
#define PG8_WAIT_V(n) asm volatile("s_waitcnt vmcnt(" #n ")" ::: "memory")
#define PG8_WAIT_L(n) asm volatile("s_waitcnt lgkmcnt(" #n ")" ::: "memory")
#define PG8_BAR __builtin_amdgcn_s_barrier()
#define PG8_SCHED __builtin_amdgcn_sched_barrier(0)
    Unit cur, nxt; int ui = 0;
    if (!S.next(0, cur)) return;
    f32x4 acc[2][2][4][2];
#pragma unroll
    for (int a = 0; a < 2; ++a)
#pragma unroll
        for (int b = 0; b < 2; ++b)
#pragma unroll
            for (int m = 0; m < 4; ++m)
#pragma unroll
                for (int n = 0; n < 2; ++n) acc[a][b][m][n] = (f32x4){0.f, 0.f, 0.f, 0.f};
    bf16x8 At[4][2], B0[2][2], B1[2][2];
    const char* cA = (const char*)g.A + (size_t)cur.pm * tstepA; const char* cB = (const char*)g.Bt + (size_t)cur.pn * tstepB;
    PG8_STAGE(PG8_SB(0, 0), cB, voffB); PG8_STAGE(PG8_SA(0, 0), cA, voffA); PG8_STAGE(PG8_SB(0, 1), cB + hstepB, voffB); PG8_STAGE(PG8_SA(0, 1), cA + hstepA, voffA);
    if (wr == 1) PG8_BAR;
    PG8_WAIT_V(4); PG8_BAR;
    PG8_STAGE(PG8_SB(1, 0), cB + kstep, voffB); PG8_STAGE(PG8_SA(1, 0), cA + kstep, voffA); PG8_STAGE(PG8_SB(1, 1), cB + hstepB + kstep, voffB);
    PG8_WAIT_V(6); PG8_BAR;
    for (;;) {
        const bool has_next = S.next(ui + 1, nxt);
        const char* nA = has_next ? (const char*)g.A + (size_t)nxt.pm * tstepA : cA; const char* nB = has_next ? (const char*)g.Bt + (size_t)nxt.pn * tstepB : cB;
        for (int t = 0; t < nt; t += 2) {
            const bool last = (t == nt - 2);
            const char* a1 = cA + (size_t)(t + 1) * kstep;
            const char* a2 = last ? nA : cA + (size_t)(t + 2) * kstep; const char* b2 = last ? nB : cB + (size_t)(t + 2) * kstep;
            const char* a3 = a2 + kstep; const char* b3 = b2 + kstep;
            PG8_LDB(B0, 0, 0); PG8_SCHED; PG8_LDA(At, 0, 0); PG8_STAGE(PG8_SA(1, 1), a1 + hstepA, voffA);
            PG8_WAIT_L(8); PG8_BAR; PG8_WAIT_L(0); PG8_MMA(0, 0, At, B0); PG8_BAR; PG8_SCHED;
            PG8_LDB(B1, 0, 1); PG8_STAGE(PG8_SB(0, 0), b2, voffB);
            PG8_BAR; PG8_WAIT_L(0); PG8_MMA(0, 1, At, B1); PG8_BAR;
            PG8_LDA(At, 0, 1); PG8_STAGE(PG8_SA(0, 0), a2, voffA);
            PG8_BAR; PG8_WAIT_L(0); PG8_MMA(1, 0, At, B0); PG8_BAR; PG8_SCHED;
            PG8_STAGE(PG8_SB(0, 1), b2 + hstepB, voffB);
            PG8_WAIT_V(6); PG8_BAR; PG8_MMA(1, 1, At, B1); PG8_BAR;
            PG8_LDB(B0, 1, 0); PG8_SCHED; PG8_LDA(At, 1, 0); PG8_STAGE(PG8_SA(0, 1), a2 + hstepA, voffA);
            PG8_WAIT_L(8); PG8_BAR; PG8_WAIT_L(0); PG8_MMA(0, 0, At, B0); PG8_BAR; PG8_SCHED;
            PG8_LDB(B1, 1, 1); PG8_STAGE(PG8_SB(1, 0), b3, voffB);
            PG8_BAR; PG8_WAIT_L(0); PG8_MMA(0, 1, At, B1); PG8_BAR;
            PG8_LDA(At, 1, 1); PG8_STAGE(PG8_SA(1, 0), a3, voffA);
            PG8_BAR; PG8_WAIT_L(0); PG8_MMA(1, 0, At, B0); PG8_BAR; PG8_SCHED;
            PG8_STAGE(PG8_SB(1, 1), b3 + hstepB, voffB);
            PG8_WAIT_V(6); PG8_BAR; PG8_MMA(1, 1, At, B1); PG8_BAR;
        }
        E(acc, cur, wr, wc, fr, fq);
        if (!has_next) break;
#pragma unroll
        for (int a = 0; a < 2; ++a)
#pragma unroll
            for (int b = 0; b < 2; ++b)
#pragma unroll
                for (int m = 0; m < 4; ++m)
#pragma unroll
                    for (int n = 0; n < 2; ++n) acc[a][b][m][n] = (f32x4){0.f, 0.f, 0.f, 0.f};
        cur = nxt; cA = nA; cB = nB; ++ui;
    }
    PG8_WAIT_V(0);
    if (wr == 0) PG8_BAR;
    PG8_BAR;
#undef PG8_SA
#undef PG8_SB
#undef PG8_STAGE
#undef PG8_LDA
#undef PG8_LDB
#undef PG8_MMA
#undef PG8_WAIT_V
#undef PG8_WAIT_L
#undef PG8_BAR
#undef PG8_SCHED
}

struct EpiRes {
    static constexpr bool PERM = true;
    const float* srcf; const bf16_t* srcb; float* dstf; bf16_t* xb; const float* colscale; stat_t* stats; int col_off;
    __device__ __forceinline__ void operator()(const f32x4 (&acc)[2][2][4][2], const Unit& u, int wr, int wc, int fr, int fq) const {
        const int row0 = u.pm * BM + wr * 64 + fr, col0 = col_off + u.pn * BM + wc * 32 + 8 * fq;
        f32x4 cs[2][2];
#pragma unroll
        for (int bj = 0; bj < 2; ++bj)
#pragma unroll
            for (int n = 0; n < 2; ++n) cs[bj][n] = colscale ? *(const f32x4*)(colscale + col0 + bj * HALF + 4 * n) : (f32x4){1.f, 1.f, 1.f, 1.f};
#pragma unroll
        for (int ai = 0; ai < 2; ++ai)
#pragma unroll
            for (int m = 0; m < 4; ++m) {
                const int row = row0 + ai * HALF + m * 16; const size_t ro = (size_t)row * D + col0; float ss = 0.f;
#pragma unroll
                for (int bj = 0; bj < 2; ++bj) {
                    const size_t o = ro + bj * HALF;
                    f32x4 s0, s1;
                    if (srcf) { s0 = *(const f32x4*)(srcf + o); s1 = *(const f32x4*)(srcf + o + 4); }
                    else { const u32x4 w = *(const u32x4*)(srcb + o); s0 = (f32x4){bf_lo(w.x), bf_hi(w.x), bf_lo(w.y), bf_hi(w.y)}; s1 = (f32x4){bf_lo(w.z), bf_hi(w.z), bf_lo(w.w), bf_hi(w.w)}; }
                    const f32x4 v0 = acc[ai][bj][m][0] * cs[bj][0] + s0, v1 = acc[ai][bj][m][1] * cs[bj][1] + s1;
                    ss += v0[0] * v0[0] + v0[1] * v0[1] + v0[2] * v0[2] + v0[3] * v0[3] + v1[0] * v1[0] + v1[1] * v1[1] + v1[2] * v1[2] + v1[3] * v1[3];
                    if (dstf) { *(f32x4*)(dstf + o) = v0; *(f32x4*)(dstf + o + 4) = v1; }
                    if (xb) { u32x4 w; w.x = cvt_pk_bf16(v0[0], v0[1]); w.y = cvt_pk_bf16(v0[2], v0[3]); w.z = cvt_pk_bf16(v1[0], v1[1]); w.w = cvt_pk_bf16(v1[2], v1[3]); *(u32x4*)(xb + o) = w; }
                }
                if (stats) { ss += __shfl_xor(ss, 16); ss += __shfl_xor(ss, 32); if (fq == 0) stat_add(stats + row, ss); }
            }
    }
};
struct EpiUp {
    static constexpr bool PERM = true;
    bf16_t* U; const stat_t* stats;
    __device__ __forceinline__ void operator()(const f32x4 (&acc)[2][2][4][2], const Unit& u, int wr, int wc, int fr, int fq) const {
        const int row0 = u.pm * BM + wr * 64 + fr, col0 = u.pn * BM + wc * 32 + 8 * fq;
#pragma unroll
        for (int ai = 0; ai < 2; ++ai)
#pragma unroll
            for (int m = 0; m < 4; ++m) {
                const int row = row0 + ai * HALF + m * 16; const float r = rinv_st(stats[row], 1.0f / 2048.0f);
                bf16_t* rowp = U + (size_t)row * FF + col0;
#pragma unroll
                for (int bj = 0; bj < 2; ++bj) {
                    f32x4 v0 = acc[ai][bj][m][0] * r, v1 = acc[ai][bj][m][1] * r;
#pragma unroll
                    for (int j = 0; j < 4; ++j) { const float a = fmaxf(v0[j], 0.f), b = fmaxf(v1[j], 0.f); v0[j] = a * a; v1[j] = b * b; }
                    u32x4 w; w.x = cvt_pk_bf16(v0[0], v0[1]); w.y = cvt_pk_bf16(v0[2], v0[3]); w.z = cvt_pk_bf16(v1[0], v1[1]); w.w = cvt_pk_bf16(v1[2], v1[3]);
                    *(u32x4*)(rowp + bj * HALF) = w;
                }
            }
    }
};
struct EpiRaw {
    static constexpr bool PERM = true;
    bf16_t* raw; const stat_t* stats;
    __device__ __forceinline__ void operator()(const f32x4 (&acc)[2][2][4][2], const Unit& u, int wr, int wc, int fr, int fq) const {
        const int row0 = u.pm * BM + wr * 64 + fr, col0 = u.pn * BM + wc * 32 + 8 * fq;
#pragma unroll
        for (int ai = 0; ai < 2; ++ai)
#pragma unroll
            for (int m = 0; m < 4; ++m) {
                const int row = row0 + ai * HALF + m * 16; const float r = rinv_st(stats[row], 1.0f / 2048.0f);
                bf16_t* rowp = raw + (size_t)row * NINP + col0;
#pragma unroll
                for (int bj = 0; bj < 2; ++bj) {
                    const f32x4 v0 = acc[ai][bj][m][0] * r, v1 = acc[ai][bj][m][1] * r;
                    u32x4 w; w.x = cvt_pk_bf16(v0[0], v0[1]); w.y = cvt_pk_bf16(v0[2], v0[3]); w.z = cvt_pk_bf16(v1[0], v1[1]); w.w = cvt_pk_bf16(v1[2], v1[3]);
                    *(u32x4*)(rowp + bj * HALF) = w;
                }
            }
    }
};
struct EpiRawT {
    static constexpr bool PERM = false;
    float* raw; const stat_t* stats;
    __device__ __forceinline__ void operator()(const f32x4 (&acc)[2][2][4][2], const Unit& u, int wr, int wc, int fr, int fq) const {
        const int row0 = u.pm * BM + wr * 64 + fr, col0 = u.pn * BM + wc * 32 + 4 * fq;
#pragma unroll
        for (int ai = 0; ai < 2; ++ai)
#pragma unroll
            for (int m = 0; m < 4; ++m) {
                const int row = row0 + ai * HALF + m * 16; const float r = rinv_st(stats[row], 1.0f / 2048.0f);
                float* rowp = raw + (size_t)row * 256 + col0;
#pragma unroll
                for (int bj = 0; bj < 2; ++bj)
#pragma unroll
                    for (int n = 0; n < 2; ++n) *(f32x4*)(rowp + bj * HALF + n * 16) = acc[ai][bj][m][n] * r;
            }
    }
};
struct EpiSgu {
    static constexpr bool PERM = true;
    bf16_t* uv; const stat_t* stats; const float* bias; stat_t* stats_v;
    __device__ __forceinline__ void operator()(const f32x4 (&acc)[2][2][4][2], const Unit& u, int wr, int wc, int fr, int fq) const {
        const int row0 = u.pm * BM + wr * 64 + fr, col0 = u.pn * BM + wc * 32 + 8 * fq;
        f32x4 bv[2][2];
#pragma unroll
        for (int bj = 0; bj < 2; ++bj)
#pragma unroll
            for (int n = 0; n < 2; ++n) bv[bj][n] = *(const f32x4*)(bias + col0 + bj * HALF + 4 * n);
        const bool isv = u.pn >= 8;
#pragma unroll
        for (int ai = 0; ai < 2; ++ai)
#pragma unroll
            for (int m = 0; m < 4; ++m) {
                const int row = row0 + ai * HALF + m * 16; const float r = rinv_st(stats[row], 1.0f / 2048.0f);
                bf16_t* rowp = uv + (size_t)row * 4096 + col0; float ss = 0.f;
#pragma unroll
                for (int bj = 0; bj < 2; ++bj) {
                    const f32x4 v0 = acc[ai][bj][m][0] * r + bv[bj][0], v1 = acc[ai][bj][m][1] * r + bv[bj][1];
                    const f32x2 a = gelu_pk((f32x2){v0[0], v0[1]}), b = gelu_pk((f32x2){v0[2], v0[3]}), c = gelu_pk((f32x2){v1[0], v1[1]}), d = gelu_pk((f32x2){v1[2], v1[3]});
                    ss += a.x * a.x + a.y * a.y + b.x * b.x + b.y * b.y + c.x * c.x + c.y * c.y + d.x * d.x + d.y * d.y;
                    u32x4 w; w.x = cvt_pk_bf16(a.x, a.y); w.y = cvt_pk_bf16(b.x, b.y); w.z = cvt_pk_bf16(c.x, c.y); w.w = cvt_pk_bf16(d.x, d.y);
                    *(u32x4*)(rowp + bj * HALF) = w;
                }
                ss += __shfl_xor(ss, 16); ss += __shfl_xor(ss, 32);
                if (isv && fq == 0) stat_add(stats_v + row, ss);
            }
    }
};
}

#define CAS __attribute__((address_space(4)))
typedef const CAS Params* PP;
struct ConvDesc { const float* src; bf16_t* dst; int K, N, Npad; const float* ks; int ntiles; };
__device__ __forceinline__ ConvDesc conv_desc(PP p, int m) {
    ConvDesc d;
    if (m < 8) { d.src = p->pool_w + (size_t)m * 512 * 512; d.dst = (bf16_t*)(p->ws + WS_WPOOL) + (size_t)m * 512 * 512; d.K = 512; d.N = 512; d.Npad = 512; d.ks = nullptr; }
    else if (m == 8) { d.src = p->attn_w_in; d.dst = (bf16_t*)(p->ws + WS_WAIN); d.K = 2048; d.N = NIN; d.Npad = NINP; d.ks = p->norm_mix + 1 * D; }
    else if (m == 9) { d.src = p->attn_w_o; d.dst = (bf16_t*)(p->ws + WS_WAO); d.K = 2048; d.N = 2048; d.Npad = 2048; d.ks = nullptr; }
    else if (m == 10) { d.src = p->sgu_w_in; d.dst = (bf16_t*)(p->ws + WS_WSIN); d.K = 2048; d.N = 4096; d.Npad = 4096; d.ks = p->norm_mix + 2 * D; }
    else if (m == 11) { d.src = p->sgu_w_o; d.dst = (bf16_t*)(p->ws + WS_WSO); d.K = 2048; d.N = 2048; d.Npad = 2048; d.ks = nullptr; }
    else if (m < 16) { const int i = m - 12; d.src = p->ffn_w_up + (size_t)i * 2048 * 8192; d.dst = (bf16_t*)(p->ws + WS_WUP) + (size_t)i * 2048 * 8192; d.K = 2048; d.N = 8192; d.Npad = 8192; d.ks = p->norm_ffn + i * D; }
    else { const int i = m - 16; d.src = p->ffn_w_down + (size_t)i * 2048 * 8192; d.dst = (bf16_t*)(p->ws + WS_WDN) + (size_t)i * 2048 * 8192; d.K = 8192; d.N = 2048; d.Npad = 2048; d.ks = nullptr; }
    d.ntiles = (d.K / 64) * (d.Npad / 128);
    return d;
}

__device__ __forceinline__ void conv_load(const int TID, const ConvDesc& d, int tile, f32x4 (&a)[2][2]) {
    const int t = TID, nkb = d.K / 64, nb = tile / nkb, kb = tile % nkb;
#pragma unroll
    for (int i = 0; i < 2; ++i) {
        const int u = t + 512 * i, nq = (u & 15) + 16 * ((u >> 6) & 1), kp = ((u >> 4) & 3) + 4 * (u >> 7);
        const int k = kb * 64 + 2 * kp, n = nb * 128 + 4 * nq;
        if (n < d.N) { a[i][0] = *(const f32x4*)(d.src + (size_t)k * d.N + n); a[i][1] = *(const f32x4*)(d.src + (size_t)(k + 1) * d.N + n); }
        else { a[i][0] = (f32x4){0.f, 0.f, 0.f, 0.f}; a[i][1] = (f32x4){0.f, 0.f, 0.f, 0.f}; }
        if (d.ks) { a[i][0] *= d.ks[k]; a[i][1] *= d.ks[k + 1]; }
    }
}

__device__ __forceinline__ void conv_phase(const int TID, const int BID, PP p, LAS unsigned* ldsw) {
    const int t = TID, G = gridDim.x;
    int m = 0; ConvDesc d = conv_desc(p, 0); int base = 0;
    int total = 0;
    for (int i = 0; i < 20; ++i) total += conv_desc(p, i).ntiles;
    int gid = BID;
    f32x4 a[2][2];
    bool have = gid < total;
    if (have) { while (gid >= base + d.ntiles) { base += d.ntiles; ++m; d = conv_desc(p, m); } conv_load(TID, d, gid - base, a); }
    while (have) {
        const ConvDesc cd = d; const int ctile = gid - base;
        __syncthreads();
#pragma unroll
        for (int i = 0; i < 2; ++i) {
            const int u = t + 512 * i, nq = (u & 15) + 16 * ((u >> 6) & 1), kp = ((u >> 4) & 3) + 4 * (u >> 7);
#pragma unroll
            for (int e = 0; e < 4; ++e) ldsw[(4 * nq + e) * 33 + kp] = cvt_pk_bf16(a[i][0][e], a[i][1][e]);
        }
        gid += G; have = gid < total;
        if (have) { while (gid >= base + d.ntiles) { base += d.ntiles; ++m; d = conv_desc(p, m); } conv_load(TID, d, gid - base, a); }
        __syncthreads();
        {
            const int nkb = cd.K / 64, nb = ctile / nkb, kb = ctile % nkb, n = t >> 2, kc = t & 3;
            unsigned w[8];
#pragma unroll
            for (int j = 0; j < 8; ++j) w[j] = ldsw[n * 33 + kc * 8 + j];
            bf16_t* o = cd.dst + (size_t)(nb * 128 + n) * cd.K + kb * 64 + kc * 16;
            *(u32x4*)o = (u32x4){w[0], w[1], w[2], w[3]}; *(u32x4*)(o + 8) = (u32x4){w[4], w[5], w[6], w[7]};
        }
    }
    __syncthreads();
}

template <bool BF> __device__ __forceinline__ f32x4 ld4(const void* base, size_t idx) {
    if (BF) { const u32x2 w = *(const u32x2*)((const bf16_t*)base + idx); return (f32x4){bf_lo(w.x), bf_hi(w.x), bf_lo(w.y), bf_hi(w.y)}; }
    else return *(const f32x4*)((const float*)base + idx);
}
template <bool BF, int W> __device__ __forceinline__ void poolp_chunk(const void* xsrc, size_t xb0, int s_base, int s0, int c, f32x4 g4, const LAS float* rinv, bf16_t* Pout) {
    f32x4 h[W + 8];
#pragma unroll
    for (int r = 0; r < W + 8; ++r) {
        const int s = s_base - W + r;
        if (s >= 0) h[r] = ld4<BF>(xsrc, xb0 + (size_t)s * D + c) * (g4 * rinv[s - s0 + 16]);
        else h[r] = (f32x4){0.f, 0.f, 0.f, 0.f};
    }
    f32x4 S = (f32x4){0.f, 0.f, 0.f, 0.f};
#pragma unroll
    for (int i = 0; i < W; ++i) S += h[i];
#pragma unroll
    for (int tt = 0; tt < 8; ++tt) {
        const int s = s_base + tt;
        S += h[W + tt] - h[tt];
        const float inv = 1.0f / (float)min(s + 1, W);
        const f32x4 pv = S * inv - h[W + tt];
        u32x2 o; o.x = cvt_pk_bf16(pv[0], pv[1]); o.y = cvt_pk_bf16(pv[2], pv[3]);
        *(u32x2*)(Pout + (size_t)tt * D) = o;
    }
}
template <bool BF> __device__ __forceinline__ void poolp_phase(const int TID, const int BID, const void* xsrc, const float* gain, bf16_t* P, LAS float* ldsf, const stat_t* stats) {
    const int t = TID, wv = t >> 6, lane = t & 63;
    for (int item = BID; item < 256; item += gridDim.x) {
        const int tok0 = item * 32, b = tok0 >> 12, s0 = tok0 & 4095;
        const size_t xb0 = (size_t)b * SEQ * D;
        if (stats) {
            if (t < 48) { const int s = s0 - 16 + t; ldsf[t] = (s >= 0) ? rinv_st(stats[b * SEQ + s], 1.0f / 2048.0f) : 0.f; }
        } else {
#pragma unroll
            for (int half = 0; half < 2; ++half) {
                f32x4 v[3][8];
#pragma unroll
                for (int k = 0; k < 3; ++k) { const int s = s0 - 16 + wv + 8 * (3 * half + k);
#pragma unroll
                    for (int i = 0; i < 8; ++i) v[k][i] = (s >= 0) ? ld4<BF>(xsrc, xb0 + (size_t)s * D + 4 * (lane + 64 * i)) : (f32x4){0.f, 0.f, 0.f, 0.f}; }
#pragma unroll
                for (int k = 0; k < 3; ++k) { float ss = 0.f;
#pragma unroll
                    for (int i = 0; i < 8; ++i) ss += v[k][i][0] * v[k][i][0] + v[k][i][1] * v[k][i][1] + v[k][i][2] * v[k][i][2] + v[k][i][3] * v[k][i][3];
                    ss = wave_sum(ss);
                    if (lane == 0) ldsf[wv + 8 * (3 * half + k)] = rinv_of(ss, 1.0f / 2048.0f); }
            }
        }
        __syncthreads();
        const int c = 4 * t; const f32x4 g4 = *(const f32x4*)(gain + c);
        for (int ch = 0; ch < 4; ++ch) {
            bf16_t* Pout = P + (size_t)(tok0 + 8 * ch) * D + c;
            switch (t >> 7) {
                case 0: poolp_chunk<BF, 2>(xsrc, xb0, s0 + 8 * ch, s0, c, g4, ldsf, Pout); break;
                case 1: poolp_chunk<BF, 4>(xsrc, xb0, s0 + 8 * ch, s0, c, g4, ldsf, Pout); break;
                case 2: poolp_chunk<BF, 8>(xsrc, xb0, s0 + 8 * ch, s0, c, g4, ldsf, Pout); break;
                default: poolp_chunk<BF, 16>(xsrc, xb0, s0 + 8 * ch, s0, c, g4, ldsf, Pout); break;
            }
        }
        __syncthreads();
    }
}

__device__ __forceinline__ void rope_cs(int pos, float inv, float& c, float& s) {
    double rev = (double)pos * (double)inv * 0.15915494309189535; rev -= __builtin_rint(rev);
    const float f = (float)rev; s = __builtin_amdgcn_sinf(f); c = __builtin_amdgcn_cosf(f);
}
__device__ __forceinline__ void prep_phase(const int TID, const int BID, PP p) {
    const int lane = TID & 63, wg = BID * 8 + (TID >> 6), nw = gridDim.x * 8;
    const bf16_t* raw = (const bf16_t*)(p->ws + WS_BIG); const float* rawt = (const float*)(p->ws + WS_RAWT);
    bf16_t* Qb = (bf16_t*)(p->ws + WS_QB); bf16_t* Kb = (bf16_t*)(p->ws + WS_KB); bf16_t* Vb = (bf16_t*)(p->ws + WS_VB);
    bf16_t* QIb = (bf16_t*)(p->ws + WS_QIB); bf16_t* KIb = (bf16_t*)(p->ws + WS_KIB); float* WI = (float*)(p->ws + WS_WI);
    const float L2T = 18.931568569324174f;
    for (int tok = wg; tok < T; tok += nw) {
        const bf16_t* r = raw + (size_t)tok * NINP; const int pos = tok & 4095;
        float cq[4], sq[4], ci[4], si[4];
        { const int j = lane & 3, ji = lane & 1;
#pragma unroll
          for (int e = 0; e < 4; ++e) {
              rope_cs(pos, exp2f(-(float)(4 * j + e) * (L2T / 16.0f)), cq[e], sq[e]);
              rope_cs(pos, exp2f(-(float)(4 * ji + e) * (L2T / 8.0f)), ci[e], si[e]); } }
#pragma unroll
        for (int it = 0; it < 10; ++it) {
            const int head = 2 * it + (lane >> 5), j = lane & 31;
            const bool isq = head < 16;
            const int col = isq ? head * 128 : 2048 + (head - 16) * 128;
            const u32x2 rw = *(const u32x2*)(r + col + 4 * j);
            f32x4 v = (f32x4){bf_lo(rw.x), bf_hi(rw.x), bf_lo(rw.y), bf_hi(rw.y)};
            float ss = v[0] * v[0] + v[1] * v[1] + v[2] * v[2] + v[3] * v[3];
#pragma unroll
            for (int o = 16; o > 0; o >>= 1) ss += __shfl_xor(ss, o);
            const float rn = rinv_of(ss, 1.0f / 128.0f);
            const f32x4 g4 = *(const f32x4*)((isq ? p->attn_q_gain : p->attn_k_gain) + 4 * j);
            v = v * rn * g4;
            f32x4 pt;
#pragma unroll
            for (int e = 0; e < 4; ++e) pt[e] = __shfl_xor(v[e], 4);
            if (j < 8) {
#pragma unroll
                for (int e = 0; e < 4; ++e) v[e] = (j < 4) ? v[e] * cq[e] - pt[e] * sq[e] : v[e] * cq[e] + pt[e] * sq[e];
            }
            u32x2 o; o.x = cvt_pk_bf16(v[0], v[1]); o.y = cvt_pk_bf16(v[2], v[3]);
            { int w8 = __builtin_amdgcn_cvt_pk_fp8_f32(v[0], v[1], 0, false); w8 = __builtin_amdgcn_cvt_pk_fp8_f32(v[2], v[3], w8, true);
              if (isq) *(int*)((unsigned char*)Qb + (size_t)tok * 2048 + head * 128 + 4 * j) = w8;
              else *(int*)((unsigned char*)Kb + (size_t)tok * 512 + (head - 16) * 128 + 4 * j) = w8; }
        }
        { const u32x4 vw = *(const u32x4*)(r + 2560 + 8 * lane);
          int lo = __builtin_amdgcn_cvt_pk_fp8_f32(bf_lo(vw.x), bf_hi(vw.x), 0, false); lo = __builtin_amdgcn_cvt_pk_fp8_f32(bf_lo(vw.y), bf_hi(vw.y), lo, true);
          int hi = __builtin_amdgcn_cvt_pk_fp8_f32(bf_lo(vw.z), bf_hi(vw.z), 0, false); hi = __builtin_amdgcn_cvt_pk_fp8_f32(bf_lo(vw.w), bf_hi(vw.w), hi, true);
          *(u32x2*)((unsigned char*)Vb + (size_t)tok * 512 + 8 * lane) = (u32x2){(unsigned)lo, (unsigned)hi}; }
#pragma unroll
        for (int it = 0; it < 5; ++it) {
            const int j = lane & 15;
            const int head = 4 * it + (lane >> 4);
            const int col = (it < 4) ? 3072 + head * 64 : 4096;
            f32x4 v;
            if (it < 4) { const u32x2 rw = *(const u32x2*)(r + col + 4 * j); v = (f32x4){bf_lo(rw.x), bf_hi(rw.x), bf_lo(rw.y), bf_hi(rw.y)}; }
            else { const float* rt = rawt + (size_t)tok * 256 + 4 * j; v = *(const f32x4*)rt + *(const f32x4*)(rt + (size_t)T * 256) + *(const f32x4*)(rt + (size_t)2 * T * 256) + *(const f32x4*)(rt + (size_t)3 * T * 256); }
            f32x4 pt;
#pragma unroll
            for (int e = 0; e < 4; ++e) pt[e] = __shfl_xor(v[e], 2);
            if (j < 4) {
#pragma unroll
                for (int e = 0; e < 4; ++e) v[e] = (j < 2) ? v[e] * ci[e] - pt[e] * si[e] : v[e] * ci[e] + pt[e] * si[e];
            }
            u32x2 o; o.x = cvt_pk_bf16(v[0], v[1]); o.y = cvt_pk_bf16(v[2], v[3]);
            if (it < 4) *(u32x2*)(QIb + (size_t)tok * 1024 + head * 64 + 4 * j) = o;
            else if (lane < 16) *(u32x2*)(KIb + (size_t)tok * 64 + 4 * j) = o;
        }
        if (lane < 16) { const float* rt = rawt + (size_t)tok * 256 + 64 + lane; WI[(size_t)tok * 16 + lane] = (rt[0] + rt[(size_t)T * 256] + rt[(size_t)2 * T * 256] + rt[(size_t)3 * T * 256]) * 0.03125f; }
    }
}

__device__ __forceinline__ void idx_phase(const int TID, const int BID, PP p, LAS unsigned char* lds) {
    const int t = TID, lane = t & 63, wv = t >> 6;
    const bf16_t* QIb = (const bf16_t*)(p->ws + WS_QIB); const bf16_t* KIb = (const bf16_t*)(p->ws + WS_KIB); const float* WI = (const float*)(p->ws + WS_WI);
    _Float16* Sc = (_Float16*)(p->ws + WS_BIG);
    const int rr = lane & 31, g2 = lane >> 5;
    for (int item = BID; item < 1088; item += gridDim.x) {
        const int b = item / 544; int rem = item % 544;
        int a = 0; while (rem >= 4 * (a + 1)) { rem -= 4 * (a + 1); ++a; }
        const int c = 4 * a + rem / (a + 1), kb = rem % (a + 1);
        const int key0 = kb * 256, Nk = (c + 1) * 64, nkeys = min(256, Nk - key0);
        bf16x8 Aq[4][4]; float wqa[4][16];
#pragma unroll
        for (int pr = 0; pr < 4; ++pr) {
            const int tokq = b * SEQ + c * 64 + wv * 8 + 2 * pr;
            const bf16_t* src = QIb + (size_t)(tokq + (rr >> 4)) * 1024 + (rr & 15) * 64 + g2 * 32;
#pragma unroll
            for (int ks = 0; ks < 4; ++ks) Aq[pr][ks] = *(const bf16x8*)(src + ks * 8);
#pragma unroll
            for (int i = 0; i < 16; ++i) wqa[pr][i] = WI[(size_t)(tokq + (i >> 3)) * 16 + 8 * ((i >> 2) & 1) + 4 * g2 + (i & 3)];
        }
        __syncthreads();
        { const int key = t >> 1, half = t & 1;
          if (key < nkeys) { const bf16_t* src = KIb + (size_t)(b * SEQ + key0 + key) * 64 + half * 32;
#pragma unroll
              for (int j = 0; j < 4; ++j) *(LAS u32x4*)(lds + key * 144 + half * 64 + j * 16) = *(const u32x4*)(src + j * 8); } }
        __syncthreads();
#pragma unroll
        for (int pr = 0; pr < 4; ++pr) {
            const int tokq = b * SEQ + c * 64 + wv * 8 + 2 * pr;
            const bf16x8 (&A)[4] = Aq[pr]; const float (&wq)[16] = wqa[pr];
            for (int kt = 0; kt < nkeys / 32; kt += 2) {
                f32x16 acc0, acc1;
#pragma unroll
                for (int i = 0; i < 16; ++i) { acc0[i] = 0.f; acc1[i] = 0.f; }
                bf16x8 Bf0[4], Bf1[4];
#pragma unroll
                for (int ks = 0; ks < 4; ++ks) { Bf0[ks] = *(const LAS bf16x8*)(lds + (kt * 32 + rr) * 144 + g2 * 64 + ks * 16); Bf1[ks] = *(const LAS bf16x8*)(lds + ((kt + 1) * 32 + rr) * 144 + g2 * 64 + ks * 16); }
#pragma unroll
                for (int ks = 0; ks < 4; ++ks) { acc0 = __builtin_amdgcn_mfma_f32_32x32x16_bf16(A[ks], Bf0[ks], acc0, 0, 0, 0); acc1 = __builtin_amdgcn_mfma_f32_32x32x16_bf16(A[ks], Bf1[ks], acc1, 0, 0, 0); }
                float s0 = 0.f, s1 = 0.f, t0 = 0.f, t1 = 0.f;
#pragma unroll
                for (int i = 0; i < 8; ++i) { s0 += relu1(acc0[i]) * wq[i]; s1 += relu1(acc0[8 + i]) * wq[8 + i]; t0 += relu1(acc1[i]) * wq[i]; t1 += relu1(acc1[8 + i]) * wq[8 + i]; }
                s0 += __shfl_xor(s0, 32); s1 += __shfl_xor(s1, 32); t0 += __shfl_xor(t0, 32); t1 += __shfl_xor(t1, 32);
                _Float16* so = Sc + (size_t)(tokq + g2) * SEQ + key0 + kt * 32 + rr;
                so[0] = (_Float16)(g2 ? s1 : s0); so[32] = (_Float16)(g2 ? t1 : t0);
            }
        }
    }
}

__device__ __forceinline__ unsigned fkey(float f) { const unsigned u = __float_as_uint(f); return (u & 0x80000000u) ? ~u : (u | 0x80000000u); }

__device__ __forceinline__ void attn_phase(const int TID, const int BID, PP p, LAS unsigned char* lds) {
    const int lane = TID & 63, wv = __builtin_amdgcn_readfirstlane(TID >> 6), wg = BID * 8 + wv, nw = gridDim.x * 8;
    const _Float16* Sc = (const _Float16*)(p->ws + WS_BIG);
    const bf16_t* Qb = (const bf16_t*)(p->ws + WS_QB); const bf16_t* Kb = (const bf16_t*)(p->ws + WS_KB); const bf16_t* Vb = (const bf16_t*)(p->ws + WS_VB);
    bf16_t* O = (bf16_t*)(p->ws + WS_AB);
    LAS unsigned short* widx = (LAS unsigned short*)(lds + wv * 512);
    LAS unsigned char* vt = lds + 4096 + wv * 16384;
    const int fr = lane & 15, fq = lane >> 4;
    for (int tok = wg; tok < T; tok += nw) {
        const int b = tok >> 12, s = tok & 4095, Nk = ((s >> 6) + 1) * 64, nsel = min(Nk, 256);
        if (Nk <= 256) {
#pragma unroll
            for (int i = 0; i < 4; ++i) { const int slot = lane + 64 * i; if (slot < Nk) widx[slot] = slot; }
        } else {
            unsigned key[64];
            int ln = lane; asm volatile("" : "+v"(ln));
            const _Float16* srow = Sc + (size_t)tok * SEQ;
#pragma unroll
            for (int i = 0; i < 16; ++i) {
                const int k0 = i * 256 + 4 * ln;
                if (k0 < Nk) { typedef _Float16 h16x4 __attribute__((ext_vector_type(4))); const h16x4 hv = *(const h16x4*)(srow + k0); const f32x4 v = (f32x4){(float)hv[0], (float)hv[1], (float)hv[2], (float)hv[3]};
#pragma unroll
                    for (int e = 0; e < 4; ++e) key[4 * i + e] = fkey(v[e]); }
                else {
#pragma unroll
                    for (int e = 0; e < 4; ++e) key[4 * i + e] = 0u; }
            }
            const int nib = (Nk + 255) >> 8;
            unsigned Tt = 0u;
            for (int bit = 31; bit >= 0; --bit) {
                const unsigned cand = Tt | (1u << bit);
                int c = 0;
#pragma unroll
                for (int ib = 0; ib < 16; ++ib)
                    if (ib < nib) {
#pragma unroll
                        for (int e = 0; e < 4; ++e) c += (key[4 * ib + e] >= cand) ? 1 : 0;
                    }
                int cnt = 0;
#pragma unroll
                for (int bp = 0; bp < 7; ++bp) cnt += __popcll(__ballot((c >> bp) & 1)) << bp;
                if (cnt >= 256) { Tt = cand; if (cnt == 256) break; }
            }
            int cnt_gt = 0;
#pragma unroll
            for (int ib = 0; ib < 16; ++ib)
                if (ib < nib) {
#pragma unroll
                    for (int e = 0; e < 4; ++e) cnt_gt += __popcll(__ballot(key[4 * ib + e] > Tt));
                }
            const int need = 256 - cnt_gt;
            int base = 0, tbase = 0;
#pragma unroll
            for (int j = 0; j < 64; ++j) if ((j >> 2) < nib) {
                const int kidx = (j >> 2) * 256 + 4 * ln + (j & 3);
                const bool gt = key[j] > Tt; const unsigned long long m1 = __ballot(gt);
                const int pre = __builtin_amdgcn_mbcnt_hi((unsigned)(m1 >> 32), __builtin_amdgcn_mbcnt_lo((unsigned)m1, 0));
                if (gt) widx[base + pre] = kidx;
                base += __popcll(m1);
                const bool eq = key[j] == Tt; const unsigned long long m2 = __ballot(eq);
                if (m2) {
                    const int pre2 = __builtin_amdgcn_mbcnt_hi((unsigned)(m2 >> 32), __builtin_amdgcn_mbcnt_lo((unsigned)m2, 0));
                    if (eq && tbase + pre2 < need) widx[cnt_gt + tbase + pre2] = kidx;
                    tbase += __popcll(m2);
                }
            }
        }
        __builtin_amdgcn_wave_barrier();
        asm volatile("s_waitcnt lgkmcnt(0)" ::: "memory");
        const bf16_t* Kbase = Kb + (size_t)(b * SEQ) * 512; const bf16_t* Vbase = Vb + (size_t)(b * SEQ) * 512;
        const int nblk = nsel >> 6;
        for (int g = 0; g < 4; ++g) {
            f32x4 sc[16];
            {
                long q8[4];
                { const unsigned char* qp = (const unsigned char*)Qb + (size_t)tok * 2048 + (g * 4 + (lane & 3)) * 128 + fq * 8;
#pragma unroll
                  for (int ks = 0; ks < 4; ++ks) q8[ks] = *(const long*)(qp + ks * 32); }
                u32x4 R[3][4];
                const unsigned char* kg = (const unsigned char*)Kb + (size_t)(b * SEQ) * 512 + g * 128 + (lane & 7) * 16;
                LAS unsigned char* ktw = vt + (lane >> 3) * 144 + (lane & 7) * 16;
                const LAS unsigned char* ktr = vt + fr * 144 + fq * 8;
                const int nst = nsel >> 5;
#define QK_LOAD(set, st) do { _Pragma("unroll") for (int i = 0; i < 4; ++i) { const int row = widx[(st) * 32 + i * 8 + (lane >> 3)] & 4095; R[set][i] = *(const u32x4*)(kg + (size_t)row * 512); } __builtin_amdgcn_sched_barrier(0); } while (0)
#define QK_STEP(set, st, more) do { \
                _Pragma("unroll") for (int i = 0; i < 4; ++i) *(LAS u32x4*)(ktw + i * 8 * 144) = R[set][i]; \
                __builtin_amdgcn_sched_barrier(0); \
                if (more) QK_LOAD(set, (st) + 3); \
                if ((st) < nst) { long af[2][4]; \
                    _Pragma("unroll") for (int tt = 0; tt < 2; ++tt) _Pragma("unroll") for (int ks = 0; ks < 4; ++ks) af[tt][ks] = *(const LAS long*)(ktr + tt * 16 * 144 + ks * 32); \
                    f32x4 a0 = (f32x4){0.f, 0.f, 0.f, 0.f}, a1 = a0, a2 = a0, a3 = a0;        \
                    a0 = __builtin_amdgcn_mfma_f32_16x16x32_fp8_fp8(af[0][0], q8[0], a0, 0, 0, 0); a1 = __builtin_amdgcn_mfma_f32_16x16x32_fp8_fp8(af[1][0], q8[0], a1, 0, 0, 0); \
                    a2 = __builtin_amdgcn_mfma_f32_16x16x32_fp8_fp8(af[0][2], q8[2], a2, 0, 0, 0); a3 = __builtin_amdgcn_mfma_f32_16x16x32_fp8_fp8(af[1][2], q8[2], a3, 0, 0, 0); \
                    a0 = __builtin_amdgcn_mfma_f32_16x16x32_fp8_fp8(af[0][1], q8[1], a0, 0, 0, 0); a1 = __builtin_amdgcn_mfma_f32_16x16x32_fp8_fp8(af[1][1], q8[1], a1, 0, 0, 0); \
                    a2 = __builtin_amdgcn_mfma_f32_16x16x32_fp8_fp8(af[0][3], q8[3], a2, 0, 0, 0); a3 = __builtin_amdgcn_mfma_f32_16x16x32_fp8_fp8(af[1][3], q8[3], a3, 0, 0, 0); \
                    sc[(st) * 2] = a0 + a2; sc[(st) * 2 + 1] = a1 + a3; } \
                else { sc[(st) * 2] = (f32x4){-INFINITY, -INFINITY, -INFINITY, -INFINITY}; sc[(st) * 2 + 1] = (f32x4){-INFINITY, -INFINITY, -INFINITY, -INFINITY}; } \
                __builtin_amdgcn_sched_barrier(0); } while (0)
                QK_LOAD(0, 0); QK_LOAD(1, 1); QK_LOAD(2, 2);
                QK_STEP(0, 0, true); QK_STEP(1, 1, true); QK_STEP(2, 2, true); QK_STEP(0, 3, true); QK_STEP(1, 4, true);
                QK_STEP(2, 5, false); QK_STEP(0, 6, false); QK_STEP(1, 7, false);
#undef QK_LOAD
#undef QK_STEP
            }
            float mx = -INFINITY;
#pragma unroll
            for (int kt = 0; kt < 16; ++kt)
#pragma unroll
                for (int i = 0; i < 4; ++i) mx = max1(mx, sc[kt][i]);
            mx = fmaxf(mx, __shfl_xor(mx, 16)); mx = fmaxf(mx, __shfl_xor(mx, 32));
            const float sl2 = 0.08838834764831845f * 1.4426950408889634f;
            float sum = 0.f; const float nmxs = -mx * sl2;
#pragma unroll
            for (int kt = 0; kt < 16; ++kt)
#pragma unroll
                for (int i = 0; i < 4; ++i) { const float e = __builtin_amdgcn_exp2f(fmaf(sc[kt][i], sl2, nmxs)); sc[kt][i] = e; sum += e; }
            sum += __shfl_xor(sum, 16); sum += __shfl_xor(sum, 32);
            const float inv = 1.0f / sum;
            float invh[4];
#pragma unroll
            for (int i = 0; i < 4; ++i) invh[i] = __shfl(inv, i);
            long Af[8];
#pragma unroll
            for (int s2 = 0; s2 < 8; ++s2) {
                int lo = __builtin_amdgcn_cvt_pk_fp8_f32(sc[2 * s2][0], sc[2 * s2][1], 0, false); lo = __builtin_amdgcn_cvt_pk_fp8_f32(sc[2 * s2][2], sc[2 * s2][3], lo, true);
                int hi = __builtin_amdgcn_cvt_pk_fp8_f32(sc[2 * s2 + 1][0], sc[2 * s2 + 1][1], 0, false); hi = __builtin_amdgcn_cvt_pk_fp8_f32(sc[2 * s2 + 1][2], sc[2 * s2 + 1][3], hi, true);
                Af[s2] = (long)(((unsigned long long)(unsigned)hi << 32) | (unsigned)lo);
            }
            f32x4 acc[8];
#pragma unroll
            for (int nt = 0; nt < 8; ++nt) acc[nt] = (f32x4){0.f, 0.f, 0.f, 0.f};
            u32x4 R[3][4];
            const unsigned char* vg = (const unsigned char*)Vb + (size_t)(b * SEQ) * 512 + g * 128 + (lane & 7) * 16;
            LAS unsigned char* vtw = vt + (lane >> 3) * 144 + (lane & 7) * 16;
            const int rho0 = lane >> 3;
            const int slot0 = 16 * (rho0 >> 2) + (rho0 & 3);
            const unsigned trb = (unsigned)(size_t)(vt + (fq * 8 + (fr >> 1)) * 144 + (fr & 1) * 8);
#define PV_LOAD(set, st) do { _Pragma("unroll") for (int i = 0; i < 4; ++i) { const int row = widx[(st) * 32 + slot0 + 4 * i] & 4095; R[set][i] = *(const u32x4*)(vg + (size_t)row * 512); } __builtin_amdgcn_sched_barrier(0); } while (0)
#define PV_TR(dst, off) asm volatile("ds_read_b64_tr_b8 %0, %1 offset:" #off : "=v"(dst) : "v"(trb) : "memory")
#define PV_STEP(set, st, more) do { \
                _Pragma("unroll") for (int i = 0; i < 4; ++i) *(LAS u32x4*)(vtw + i * 8 * 144) = R[set][i]; \
                __builtin_amdgcn_sched_barrier(0); \
                if (more) PV_LOAD(set, (st) + 3); \
                u32x2 b0[8]; \
                PV_TR(b0[0], 0); PV_TR(b0[1], 16); PV_TR(b0[2], 32); PV_TR(b0[3], 48); PV_TR(b0[4], 64); PV_TR(b0[5], 80); PV_TR(b0[6], 96); PV_TR(b0[7], 112); \
                asm volatile("s_waitcnt lgkmcnt(0)" : "+v"(b0[0]), "+v"(b0[1]), "+v"(b0[2]), "+v"(b0[3]), "+v"(b0[4]), "+v"(b0[5]), "+v"(b0[6]), "+v"(b0[7]) :: "memory"); \
                _Pragma("unroll") for (int nt = 0; nt < 8; ++nt) \
                    acc[nt] = __builtin_amdgcn_mfma_f32_16x16x32_fp8_fp8(Af[st], __builtin_bit_cast(long, b0[nt]), acc[nt], 0, 0, 0); \
                __builtin_amdgcn_sched_barrier(0); } while (0)
            PV_LOAD(0, 0); PV_LOAD(1, 1); PV_LOAD(2, 2);
            PV_STEP(0, 0, true); PV_STEP(1, 1, true); PV_STEP(2, 2, true); PV_STEP(0, 3, true); PV_STEP(1, 4, true);
            PV_STEP(2, 5, false); PV_STEP(0, 6, false); PV_STEP(1, 7, false);
#undef PV_LOAD
#undef PV_TR
#undef PV_STEP
#pragma unroll
            for (int nt = 0; nt < 8; ++nt)
                if ((nt >> 1) == fq) {
#pragma unroll
                    for (int i = 0; i < 4; ++i) O[(size_t)tok * 2048 + (g * 4 + i) * 128 + nt * 16 + fr] = (bf16_t)(cvt_pk_bf16(acc[nt][i] * invh[i], 0.f) & 0xffffu);
                }
        }
        __builtin_amdgcn_wave_barrier();
    }
}

__device__ __forceinline__ void mix_phase(const int TID, const int BID, PP p, LAS unsigned char* lds) {
    const int t = TID, lane = t & 63, wv = t >> 6;
    const bf16_t* uv = (const bf16_t*)(p->ws + WS_BIG); const stat_t* stats_v = (const stat_t*)(p->ws + WS_STATS) + 4 * T;
    bf16_t* AB = (bf16_t*)(p->ws + WS_AB);
    LAS float* rinv = (LAS float*)lds; LAS unsigned char* Wsl = lds + 1024; LAS unsigned char* Vt = lds + 1024 + 128 * 272;
    const int rr = lane & 31, g2 = lane >> 5, it_ = wv & 3, ch = wv >> 2;
    for (int item = BID; item < 512; item += gridDim.x) {
        const int n = item >> 3, g = item & 7;
        __syncthreads();
        if (t < 128) rinv[t] = rinv_st(stats_v[n * 128 + t], 1.0f / 2048.0f);
        __syncthreads();
        { const int i = t >> 2, jseg = (t & 3) * 32; const float* wsrc = p->sgu_w_s + ((size_t)g * 128 + i) * 128 + jseg;
#pragma unroll
          for (int q = 0; q < 4; ++q) {
              f32x4 a = *(const f32x4*)(wsrc + q * 8), bq = *(const f32x4*)(wsrc + q * 8 + 4);
              const int j0 = jseg + q * 8; const bool ok = (j0 >> 6) <= (i >> 6);
              u32x4 w;
              if (ok) { w.x = cvt_pk_bf16(a[0] * rinv[j0], a[1] * rinv[j0 + 1]); w.y = cvt_pk_bf16(a[2] * rinv[j0 + 2], a[3] * rinv[j0 + 3]);
                        w.z = cvt_pk_bf16(bq[0] * rinv[j0 + 4], bq[1] * rinv[j0 + 5]); w.w = cvt_pk_bf16(bq[2] * rinv[j0 + 6], bq[3] * rinv[j0 + 7]); }
              else w = (u32x4){0u, 0u, 0u, 0u};
              *(LAS u32x4*)(Wsl + i * 272 + j0 * 2) = w;
          } }
        { const int j = t & 127, cgp = t >> 7; const bf16_t* vsrc = uv + (size_t)(n * 128 + j) * 4096 + 2048 + g * 256;
#pragma unroll
          for (int q = 0; q < 8; ++q) {
              const int c = (q * 4 + cgp) * 8; const u32x4 v = *(const u32x4*)(vsrc + c);
#pragma unroll
              for (int e = 0; e < 4; ++e) { *(LAS bf16_t*)(Vt + (c + 2 * e) * 272 + j * 2) = (bf16_t)(v[e] & 0xffffu); *(LAS bf16_t*)(Vt + (c + 2 * e + 1) * 272 + j * 2) = (bf16_t)(v[e] >> 16); }
          } }
        __syncthreads();
        f32x16 acc[4];
#pragma unroll
        for (int ct = 0; ct < 4; ++ct)
#pragma unroll
            for (int i = 0; i < 16; ++i) acc[ct][i] = 0.f;
#pragma unroll
        for (int ks = 0; ks < 8; ++ks) {
            const bf16x8 Af = *(const LAS bf16x8*)(Wsl + (it_ * 32 + rr) * 272 + (ks * 16 + g2 * 8) * 2);
#pragma unroll
            for (int ct = 0; ct < 4; ++ct) { const bf16x8 Bf = *(const LAS bf16x8*)(Vt + (ch * 128 + ct * 32 + rr) * 272 + (ks * 16 + g2 * 8) * 2); acc[ct] = __builtin_amdgcn_mfma_f32_32x32x16_bf16(Af, Bf, acc[ct], 0, 0, 0); }
        }
#pragma unroll
        for (int ct = 0; ct < 4; ++ct) {
            const int cg_ = g * 256 + ch * 128 + ct * 32 + rr; const float gain = p->sgu_v_gain[cg_];
#pragma unroll
            for (int r = 0; r < 16; ++r) {
                const int i = it_ * 32 + (r & 3) + 8 * (r >> 2) + 4 * g2; const size_t tok = (size_t)n * 128 + i;
                const float mixed = gain * acc[ct][r] + p->sgu_b_s[g * 128 + i];
                const float uval = __uint_as_float((unsigned)uv[tok * 4096 + cg_] << 16);
                AB[tok * 2048 + cg_] = (bf16_t)(cvt_pk_bf16(uval * mixed, 0.f) & 0xffffu);
            }
        }
    }
}

#define XB_TMO      128
#define XB_XCNT(j)  (256  + 64 * (j))
#define XB_XSUB(j)  (1280 + 64 * (j))
#define XB_XGEN(j)  (2304 + 64 * (j))
#define XB_TOP      3328
#define XB_TOPGEN   3392
#define XCD_BAR_WORDS 3456
#define XB_SPIN_CAP (1u << 22)
__device__ __forceinline__ unsigned xb_ld(unsigned* p)              { return __hip_atomic_load(p, __ATOMIC_RELAXED, __HIP_MEMORY_SCOPE_AGENT); }
__device__ __forceinline__ unsigned xb_add(unsigned* p, unsigned v) { return __hip_atomic_fetch_add(p, v, __ATOMIC_RELAXED, __HIP_MEMORY_SCOPE_AGENT); }
__device__ __forceinline__ unsigned xb_xcc_id() { return (unsigned)__builtin_amdgcn_s_getreg((3 << 11) | 20) & 0xFu; }
#define XB_SPIN(cond, bar) do { unsigned _sp = 0; while (cond) { __builtin_amdgcn_s_sleep(1); \
    if ((++_sp & 255u) == 0u) { if (xb_ld(&(bar)[XB_TMO])) break; if (_sp > XB_SPIN_CAP) { atomicAdd(&(bar)[XB_TMO], 1u); break; } } } } while (0)
__device__ __forceinline__ void xcd_barrier_complete(unsigned* bar, unsigned x, unsigned& nloc, unsigned& nx) {
    const unsigned G = gridDim.x * gridDim.y * gridDim.z;
    unsigned sum, cnt, mine, sp = 0u;
    for (;;) {
        sum = 0u; cnt = 0u; mine = 0u;
#pragma unroll
        for (unsigned j = 0; j < 16; ++j) { const unsigned c = xb_ld(&bar[XB_XCNT(j)]); sum += c; cnt += (c > 0u) ? 1u : 0u; mine = (j == x) ? c : mine; }
        if (sum == G) break;
        __builtin_amdgcn_s_sleep(1);
        if ((++sp & 255u) == 0u) { if (xb_ld(&bar[XB_TMO])) break; if (sp > XB_SPIN_CAP) { atomicAdd(&bar[XB_TMO], 1u); break; } }
    }
    nloc = mine > 0u ? mine : 1u; nx = cnt > 0u ? cnt : 1u;
}
__device__ __forceinline__ void xcd_barrier(unsigned* bar, volatile LAS unsigned* st) {
    asm volatile("s_waitcnt vmcnt(0)" ::: "memory");
    __syncthreads();
    if (threadIdx.x == 0) {
        const unsigned x = xb_xcc_id();
        __builtin_amdgcn_s_waitcnt(0);
        unsigned nloc = st[0], nx = st[1];
        if (nloc == 0u) { xcd_barrier_complete(bar, x, nloc, nx); st[0] = nloc; st[1] = nx; }
        const unsigned old = xb_add(&bar[XB_XSUB(x)], 1u);
        const unsigned gen = old / nloc;
        if (old + 1u == (gen + 1u) * nloc) {
            __builtin_amdgcn_fence(__ATOMIC_RELEASE, "agent");
            asm volatile("s_waitcnt vmcnt(0)" ::: "memory");
            const unsigned og = xb_add(&bar[XB_TOP], 1u);
            const unsigned tg = og / nx;
            if (og + 1u == (tg + 1u) * nx) xb_add(&bar[XB_TOPGEN], 1u);
            else XB_SPIN(xb_ld(&bar[XB_TOPGEN]) == tg, bar);
            __builtin_amdgcn_fence(__ATOMIC_ACQUIRE, "agent");
            xb_add(&bar[XB_XGEN(x)], 1u);
            asm volatile("s_waitcnt vmcnt(0)" ::: "memory");
        } else {
            XB_SPIN(xb_ld(&bar[XB_XGEN(x)]) == gen, bar);
            __builtin_amdgcn_fence(__ATOMIC_ACQUIRE, "agent");
            asm volatile("s_waitcnt vmcnt(0)" ::: "memory");
        }
    }
    __syncthreads();
}

__global__ __launch_bounds__(512, 2) void mega(Params p_) {
    extern __shared__ __attribute__((aligned(16))) unsigned char shm[];
    cg::grid_group grid = cg::this_grid();
    const int ph_lo = p_.phase_lo, ph_hi = p_.phase_hi;
    {
        volatile LAS unsigned* st0 = (volatile LAS unsigned*)((LAS unsigned char*)shm + LDS_BYTES);
        if (threadIdx.x == 0) { st0[0] = 0u; st0[1] = 0u; (void)xb_add(&((unsigned*)(p_.ws + WS_BAR))[XB_XCNT(xb_xcc_id())], 1u); }
        __syncthreads();
    }
    for (int it_ = ph_lo; it_ < ph_hi; ++it_) {
        if (ph_hi > 1000000) grid.sync();
        if (it_ > ph_lo) {
            PP pb = (PP)__builtin_amdgcn_kernarg_segment_ptr(); asm volatile("" : "+s"(pb));
            xcd_barrier((unsigned*)(pb->ws + WS_BAR), (volatile LAS unsigned*)((LAS unsigned char*)shm + LDS_BYTES));
        }
        const int ph = (REPEAT_PH >= 0 && it_ > REPEAT_PH) ? it_ - 1 : it_;
        PP p = (PP)__builtin_amdgcn_kernarg_segment_ptr();
        asm volatile("" : "+s"(p));
        int TID = threadIdx.x, BID = blockIdx.x; LAS unsigned char* lds = (LAS unsigned char*)shm;
        asm volatile("" : "+v"(TID)); asm volatile("" : "+s"(BID)); asm volatile("" : "+s"(lds));
        bf16_t* XB = (bf16_t*)(p->ws + WS_XB); bf16_t* AB = (bf16_t*)(p->ws + WS_AB);
        stat_t* STATS = (stat_t*)(p->ws + WS_STATS);
        int kind;
        switch (ph) {
            case 0: kind = 0; break;
            case 1: case 3: case 8: case 10: case 13: case 15: case 17: case 19: kind = 1; break;
            case 2: case 9: case 14: case 18: kind = 2; break;
            case 4: kind = 3; break;
            case 5: kind = 4; break;
            case 6: kind = 5; break;
            case 7: kind = 6; break;
            case 11: kind = 7; break;
            case 12: kind = 8; break;
            default: kind = 9; break;
        }
        if (kind == 0) {
            for (int i = BID * 512 + TID; i < 8 * T; i += gridDim.x * 512) STATS[i] = 0ull;
            conv_phase(TID, BID, p, (LAS unsigned*)lds);
            poolp_phase<false>(TID, BID, p->x, p->norm_mix, AB, (LAS float*)lds, nullptr);
        } else if (kind == 9) {
            poolp_phase<true>(TID, BID, XB, p->norm_mix + 3 * D, AB, (LAS float*)lds, STATS + 6 * T);
        } else if (kind == 1) {
            pg8::Gemm g; pg8::EpiRes E; int ngroups = 1;
            g.M = T; E.col_off = 0; E.colscale = nullptr; E.srcf = nullptr; E.srcb = XB; E.dstf = nullptr; E.xb = XB;
            if (ph == 1 || ph == 17) {
                const int j = (ph == 17);
                g.A = AB; g.lda = D; g.Bt = (const bf16_t*)(p->ws + WS_WPOOL) + (size_t)j * 4 * 512 * 512; g.ldb = 512; g.N = 512; g.K = 512; ngroups = 4;
                E.colscale = p->pool_scale + j * D; if (!j) E.srcf = p->x; E.stats = STATS + (j ? 7 : 0) * T;
            } else if (ph == 8) { g.A = AB; g.lda = D; g.Bt = (const bf16_t*)(p->ws + WS_WAO); g.ldb = 2048; g.N = 2048; g.K = 2048; E.stats = STATS + 2 * T; }
            else if (ph == 13) { g.A = AB; g.lda = D; g.Bt = (const bf16_t*)(p->ws + WS_WSO); g.ldb = 2048; g.N = 2048; g.K = 2048; E.stats = STATS + 5 * T; }
            else {
                const int L = (ph == 3) ? 0 : (ph == 10) ? 1 : (ph == 15) ? 2 : 3;
                g.A = (const bf16_t*)(p->ws + WS_BIG); g.lda = FF; g.Bt = (const bf16_t*)(p->ws + WS_WDN) + (size_t)L * 2048 * 8192; g.ldb = 8192; g.N = 2048; g.K = 8192;
                E.stats = (L == 0) ? STATS + 1 * T : (L == 1) ? STATS + 3 * T : (L == 2) ? STATS + 6 * T : nullptr;
                if (L == 3) { E.dstf = p->out; E.xb = nullptr; }
            }
            const bf16_t* A0 = g.A; const bf16_t* B0 = g.Bt;
            for (int gi = 0; gi < ngroups; ++gi) {
                g.A = A0 + gi * 512; g.Bt = B0 + (size_t)gi * 512 * 512; E.col_off = gi * 512;
                pg8::StaticOrder S; S.init(g.M, g.N, (int)gridDim.x, (int)((BID + gi * (gridDim.x / 4)) % gridDim.x));
                pg8::gemm_phase<pg8::EpiRes>(TID, BID, lds, g, S, E);
            }
        } else if (kind == 2) {
            const int L = (ph == 2) ? 0 : (ph == 9) ? 1 : (ph == 14) ? 2 : 3;
            pg8::Gemm g; g.A = XB; g.lda = D; g.Bt = (const bf16_t*)(p->ws + WS_WUP) + (size_t)L * 2048 * 8192; g.ldb = 2048; g.M = T; g.N = FF; g.K = 2048;
            pg8::EpiUp E; E.U = (bf16_t*)(p->ws + WS_BIG); E.stats = STATS + ((L == 0) ? 0 : (L == 1) ? 2 : (L == 2) ? 5 : 7) * T;
            pg8::StaticOrder S; S.init(g.M, g.N, (int)gridDim.x, (int)BID);
            pg8::gemm_phase<pg8::EpiUp>(TID, BID, lds, g, S, E);
        } else if (kind == 3) {
            pg8::Gemm g; g.A = XB; g.lda = D; g.Bt = (const bf16_t*)(p->ws + WS_WAIN); g.ldb = 2048; g.M = T; g.N = 4096; g.K = 2048;
            pg8::EpiRaw E; E.raw = (bf16_t*)(p->ws + WS_BIG); E.stats = STATS + 1 * T;
            { pg8::StaticOrder S; S.init(g.M, g.N, (int)gridDim.x, BID); pg8::gemm_phase<pg8::EpiRaw>(TID, BID, lds, g, S, E); }
            pg8::EpiRawT ET; ET.stats = STATS + 1 * T;
            for (int kq = 0; kq < 4; ++kq) {
                g.A = XB + kq * 512; g.Bt = (const bf16_t*)(p->ws + WS_WAIN) + (size_t)4096 * 2048 + kq * 512; g.N = 256; g.K = 512;
                ET.raw = (float*)(p->ws + WS_RAWT) + (size_t)kq * T * 256;
                pg8::StaticOrder S; S.init(g.M, g.N, (int)gridDim.x, (int)((BID + gridDim.x - 32 * kq) % gridDim.x));
                pg8::gemm_phase<pg8::EpiRawT>(TID, BID, lds, g, S, ET);
            }
        } else if (kind == 4) {
            prep_phase(TID, BID, p);
        } else if (kind == 5) {
            idx_phase(TID, BID, p, lds);
        } else if (kind == 6) {
            attn_phase(TID, BID, p, lds);
        } else if (kind == 7) {
            pg8::Gemm g; g.A = XB; g.lda = D; g.Bt = (const bf16_t*)(p->ws + WS_WSIN); g.ldb = 2048; g.M = T; g.N = 4096; g.K = 2048;
            pg8::EpiSgu E; E.uv = (bf16_t*)(p->ws + WS_BIG); E.stats = STATS + 3 * T; E.bias = p->sgu_b_in; E.stats_v = STATS + 4 * T;
            pg8::StaticOrder S; S.init(g.M, g.N, (int)gridDim.x, (int)BID);
            pg8::gemm_phase<pg8::EpiSgu>(TID, BID, lds, g, S, E);
        } else {
            mix_phase(TID, BID, p, lds);
        }
    }
}

extern "C" void kernel_launch(void* const* d_in, const int* in_sizes, int n_in, void* d_out, int out_size, void* d_ws, size_t ws_size, hipStream_t stream) {
    static int grid = 0;
    if (grid == 0) {
        if (n_in != 17 || ws_size < WS_END) { fprintf(stderr, "kernel_launch: unexpected n_in %d or ws_size %zu (< %zu)\n", n_in, ws_size, (size_t)WS_END); grid = -1; return; }
        int dev = 0, cus = 0, per_cu = 0;
        hipGetDevice(&dev); hipDeviceGetAttribute(&cus, hipDeviceAttributeMultiprocessorCount, dev);
        if (hipFuncSetAttribute((const void*)mega, hipFuncAttributeMaxDynamicSharedMemorySize, LDS_BYTES + 16) != hipSuccess) { fprintf(stderr, "kernel_launch: hipFuncSetAttribute failed\n"); grid = -1; return; }
        if (hipOccupancyMaxActiveBlocksPerMultiprocessor(&per_cu, (const void*)mega, 512, LDS_BYTES + 16) != hipSuccess || per_cu < 1) { fprintf(stderr, "kernel_launch: occupancy query gave %d\n", per_cu); per_cu = 1; }
        (void)hipGetLastError();
        grid = cus * 1;
        fprintf(stderr, "kernel_launch: cus %d per_cu %d grid %d\n", cus, per_cu, grid);
    }
    if (grid < 0) return;
    (void)hipMemsetAsync((unsigned char*)d_ws + WS_BAR, 0, 16384, stream);
    Params p{};
    const float** pp = (const float**)&p;
    for (int i = 0; i < 17; ++i) pp[i] = (const float*)d_in[i];
    p.out = (float*)d_out; p.ws = (unsigned char*)d_ws;
#if ONE_LAUNCH
    p.phase_lo = 0; p.phase_hi = NPHASE + (REPEAT_PH >= 0 ? 1 : 0);
    void* args[] = {&p};
    hipError_t e = hipLaunchCooperativeKernel((const void*)mega, dim3(grid), dim3(512), args, LDS_BYTES + 16, stream);
    if (e != hipSuccess) fprintf(stderr, "cooperative launch failed: %s (grid %d)\n", hipGetErrorString(e), grid);
#else
    for (int ph = 0; ph < NPHASE; ++ph) {
        p.phase_lo = ph; p.phase_hi = ph + 1;
        hipLaunchKernelGGL(mega, dim3(grid), dim3(512), LDS_BYTES + 16, stream, p);
    }
#endif
}
```
